# Optimizing an MI355X kernel written in HIP

```python
import jax, jax.numpy as jnp
from jax import lax
import numpy as np

D_MODEL = 1024
BATCH = 16
SEQ = 2048
DEPTH = 1

D_RWKV = 512
HEAD_SIZE = 64
N_RWKV_HEADS = D_RWKV // HEAD_SIZE
D_CONV = D_MODEL - D_RWKV
CONV_WIDTH = 31
D_DECAY_LORA = 64
D_AAA_LORA = 64
D_GATE_LORA = 128
D_FF = 4 * D_MODEL
RMS_EPS = 1e-6
GN_EPS = 64e-5
LN_EPS = 1e-5
D_RWKV_IN = 3 * D_RWKV + D_DECAY_LORA + D_AAA_LORA + D_GATE_LORA
D_IN = D_RWKV_IN + 2 * D_CONV

kernel_name = "hymba_rwkv7_conformer_conv_hybrid"


def rmsnorm(x, g):
    xf = x.astype(jnp.float32)
    y = xf * lax.rsqrt(jnp.mean(xf * xf, axis=-1, keepdims=True) + RMS_EPS)
    return (y * g.astype(jnp.float32)).astype(x.dtype)


def token_shift(p):
    return jnp.pad(p[:, :-1], ((0, 0), (1, 0), (0, 0)))


def rwkv7_recurrence(r, decay, k, v, a_vec, b_vec):
    B, T, H, N = r.shape
    xs = tuple(jnp.swapaxes(t, 0, 1) for t in (r, decay, k, v, a_vec, b_vec))

    def step(S, inp):
        r_t, w_t, k_t, v_t, a_t, b_t = inp
        sa = jnp.einsum('bhvk,bhk->bhv', S, a_t)
        S = S * w_t[:, :, None, :] + sa[..., :, None] * b_t[:, :, None, :] + v_t[..., :, None] * k_t[:, :, None, :]
        y = jnp.einsum('bhvk,bhk->bhv', S, r_t)
        return S, y

    S0 = jnp.zeros((B, H, N, N), jnp.float32)
    _, ys = lax.scan(step, S0, xs)
    return jnp.swapaxes(ys, 0, 1)


def rwkv7_group(p, w0, w_decay_up, a0, w_aaa_up, w_gate_up, k_k, k_a, r_k, ln_x_g, ln_x_b):
    B, T, _ = p.shape
    o = 0
    r = p[..., o:o + D_RWKV]; o += D_RWKV
    k = p[..., o:o + D_RWKV]; o += D_RWKV
    v = p[..., o:o + D_RWKV]; o += D_RWKV
    w_down = p[..., o:o + D_DECAY_LORA]; o += D_DECAY_LORA
    a_down = p[..., o:o + D_AAA_LORA]; o += D_AAA_LORA
    g_down = p[..., o:o + D_GATE_LORA]

    w_raw = -jax.nn.softplus(-(w0 + jnp.tanh(w_down) @ w_decay_up).astype(jnp.float32)) - 0.5
    decay = jnp.exp(-jnp.exp(w_raw))
    a = jax.nn.sigmoid(a0 + a_down @ w_aaa_up)
    g = jax.nn.sigmoid(g_down) @ w_gate_up

    heads = lambda t: t.reshape(B, T, N_RWKV_HEADS, HEAD_SIZE).astype(jnp.float32)
    kk = heads(k * k_k)
    kk = kk / jnp.maximum(jnp.linalg.norm(kk, axis=-1, keepdims=True), 1e-12)
    k = k * (1.0 + (a - 1.0) * k_a)

    rh, kh, vh, ah = heads(r), heads(k), heads(v), heads(a)
    y = rwkv7_recurrence(rh, heads(decay), kh, vh, -kk, kk * ah)

    mu = jnp.mean(y, axis=-1, keepdims=True)
    var = jnp.mean(jnp.square(y - mu), axis=-1, keepdims=True)
    y = (y - mu) * lax.rsqrt(var + GN_EPS)
    y = y.reshape(B, T, D_RWKV) * ln_x_g + ln_x_b
    bonus = jnp.sum(rh * kh * heads(jnp.broadcast_to(r_k, r.shape)), axis=-1, keepdims=True) * vh
    y = y + bonus.reshape(B, T, D_RWKV)
    return (y * g).astype(p.dtype)


def conformer_conv_group(u, conv_w, conv_b, conv_ln_g, conv_ln_b):
    h = u[..., :D_CONV] * jax.nn.sigmoid(u[..., D_CONV:])
    h = lax.conv_general_dilated(
        h, conv_w[:, None, :].astype(h.dtype), window_strides=(1,),
        padding=[(CONV_WIDTH - 1, 0)],
        dimension_numbers=('NWC', 'WIO', 'NWC'),
        feature_group_count=D_CONV) + conv_b
    hf = h.astype(jnp.float32)
    mu = jnp.mean(hf, axis=-1, keepdims=True)
    var = jnp.mean(jnp.square(hf - mu), axis=-1, keepdims=True)
    hn = (hf - mu) * lax.rsqrt(var + LN_EPS) * conv_ln_g + conv_ln_b
    return jax.nn.silu(hn).astype(u.dtype)


def setup_inputs(seed: int = 0) -> dict:
    key = jax.random.key(seed)
    ks = jax.random.split(key, 24)
    f32 = jnp.float32
    nrm = lambda k, shape, s: jax.random.normal(k, shape, f32) * s
    L = DEPTH
    decay_base = jnp.linspace(-6.5, -1.5, D_RWKV, dtype=f32)
    return {
        "x": jax.random.normal(ks[0], (BATCH, SEQ, D_MODEL), f32),
        "norm_mix_g": 1.0 + nrm(ks[1], (L, D_MODEL), 0.02),
        "w_in": nrm(ks[2], (L, D_MODEL, D_IN), D_MODEL ** -0.5),
        "shift_mu": jax.random.uniform(ks[3], (L, D_RWKV_IN), f32, 0.2, 0.8),
        "w0": decay_base[None, :] + nrm(ks[4], (L, D_RWKV), 0.1),
        "w_decay_up": nrm(ks[5], (L, D_DECAY_LORA, D_RWKV), 0.3 * D_DECAY_LORA ** -0.5),
        "a0": nrm(ks[6], (L, D_RWKV), 0.1),
        "w_aaa_up": nrm(ks[7], (L, D_AAA_LORA, D_RWKV), 0.3 * D_AAA_LORA ** -0.5),
        "w_gate_up": nrm(ks[8], (L, D_GATE_LORA, D_RWKV), D_GATE_LORA ** -0.5),
        "k_k": 0.85 + nrm(ks[9], (L, D_RWKV), 0.02),
        "k_a": 1.0 + nrm(ks[10], (L, D_RWKV), 0.02),
        "r_k": nrm(ks[11], (L, D_RWKV), 0.1),
        "ln_x_g": 1.0 + nrm(ks[12], (L, D_RWKV), 0.02),
        "ln_x_b": nrm(ks[13], (L, D_RWKV), 0.01),
        "conv_w": nrm(ks[14], (L, CONV_WIDTH, D_CONV), CONV_WIDTH ** -0.5),
        "conv_b": nrm(ks[15], (L, D_CONV), 0.01),
        "conv_ln_g": 1.0 + nrm(ks[16], (L, D_CONV), 0.02),
        "conv_ln_b": nrm(ks[17], (L, D_CONV), 0.01),
        "w_out": nrm(ks[18], (L, D_MODEL, D_MODEL), D_MODEL ** -0.5),
        "norm_mlp_g": 1.0 + nrm(ks[19], (L, D_MODEL), 0.02),
        "w_ff1": nrm(ks[20], (L, D_MODEL, D_FF), D_MODEL ** -0.5),
        "w_ff2": nrm(ks[21], (L, D_FF, D_MODEL), D_FF ** -0.5),
        "norm_final_g": 1.0 + nrm(ks[22], (D_MODEL,), 0.02),
    }


def reference(x, norm_mix_g, w_in, shift_mu, w0, w_decay_up, a0, w_aaa_up, w_gate_up,
              k_k, k_a, r_k, ln_x_g, ln_x_b, conv_w, conv_b, conv_ln_g, conv_ln_b,
              w_out, norm_mlp_g, w_ff1, w_ff2, norm_final_g):
    for l in range(DEPTH):
        h = rmsnorm(x, norm_mix_g[l])
        p = h @ w_in[l]
        p_rwkv = p[..., :D_RWKV_IN]
        p_rwkv = p_rwkv + (token_shift(p_rwkv) - p_rwkv) * shift_mu[l]
        p_conv = p[..., D_RWKV_IN:]
        y_rwkv = rwkv7_group(p_rwkv, w0[l], w_decay_up[l], a0[l], w_aaa_up[l], w_gate_up[l],
                             k_k[l], k_a[l], r_k[l], ln_x_g[l], ln_x_b[l])
        y_conv = conformer_conv_group(p_conv, conv_w[l], conv_b[l], conv_ln_g[l], conv_ln_b[l])
        x = x + jnp.concatenate([y_rwkv, y_conv], axis=-1) @ w_out[l]
        h = rmsnorm(x, norm_mlp_g[l])
        x = x + jnp.square(jax.nn.relu(h @ w_ff1[l])) @ w_ff2[l]
    return rmsnorm(x, norm_final_g)
```

```cpp
#include <hip/hip_runtime.h>
#include <cstdio>
#include <cstdint>
#define MK_N_LAUNCHES 1
namespace pg8 {
#define PG8_LAS __attribute__((address_space(3)))
typedef unsigned short bf16_t;
typedef short bf16x8 __attribute__((ext_vector_type(8)));
typedef float f32x4 __attribute__((ext_vector_type(4)));
typedef unsigned u32x4 __attribute__((ext_vector_type(4)));
constexpr int BM = 256, BK = 64, HALF = 128, HTB = HALF * BK * 2  , STAGE_BYTES = 8 * HTB, NXCD = 8, WGM = 8;

__host__ __device__ __forceinline__ int lds_byte(int r, int c) { const int st = (r >> 4) * 2 + (c >> 5), rr = r & 15, cc = c & 31, ob = rr * 64 + cc * 2; return st * 1024 + (ob ^ (((ob >> 9) & 1) << 5)); }
__host__ __device__ __forceinline__ void stage_rc(int b, int& R, int& C) { const int st = b / 1024, sb = b % 1024, swz = sb ^ (((sb >> 9) & 1) << 5); R = (st >> 1) * 16 + swz / 64; C = (st & 1) * 32 + (swz % 64) / 2; }
__host__ __device__ __forceinline__ int perm32(int rho) { const int n = rho >> 4, i = rho & 15; return 8 * (i >> 2) + 4 * n + (i & 3); }

struct Unit { int pm, pn; };
struct Gemm { const bf16_t* A; const bf16_t* Bt; int M, N, K; };

struct StaticOrder {
    int nM, nN, nwg, G, c;
    __host__ __device__ void init(int M, int N, int G_, int c_) { nM = M / BM; nN = N / BM; nwg = nM * nN; G = G_; c = c_; }
    __host__ __device__ bool next(int i, Unit& u) const {
        const long L = (long)i * G + c; if (L >= nwg) return false;
        int wgid = (int)L; { const int q = nwg / NXCD, r = nwg % NXCD, xcd = wgid % NXCD, off = wgid / NXCD; wgid = (xcd < r ? xcd * (q + 1) : r * (q + 1) + (xcd - r) * q) + off; }
        const int nig = WGM * nN, gid = wgid / nig, fm = gid * WGM, gsz = (nM - fm) < WGM ? (nM - fm) : WGM;
        u.pm = fm + ((wgid % nig) % gsz); u.pn = (wgid % nig) / gsz; return true;
    }
    __device__ __forceinline__ void a_ready(const Unit&) const {}
    __device__ __forceinline__ void done(const Unit&) const {}
};

__device__ __forceinline__ unsigned cvt_pk_bf16(float lo, float hi) { unsigned r; asm volatile("v_cvt_pk_bf16_f32 %0, %1, %2" : "=v"(r) : "v"(lo), "v"(hi)); return r; }
typedef float f32x2 __attribute__((ext_vector_type(2)));
template <int ACT, int RS> struct EpiBf16RS {
    static constexpr bool PERM = true, AFTER_DRAIN = false;
    bf16_t* O; int ldc; const float* rs; float eps;
    __device__ __forceinline__ void operator()(const f32x4 (&acc)[2][2][4][2], const Unit& u, int wr, int wc, int fr, int fq) const {
        const int row0 = u.pm * BM + wr * 64 + fr; const int col0 = u.pn * BM + wc * 32 + 8 * fq;
#pragma unroll
        for (int ai = 0; ai < 2; ++ai)
#pragma unroll
            for (int m = 0; m < 4; ++m) { const int row = row0 + ai * HALF + m * 16; bf16_t* rowp = O + (size_t)row * ldc + col0;
                float sc = 1.f;
                if (RS == 1) sc = rs[row];
                if (RS == 2) { const f32x4* p4 = (const f32x4*)(rs + (size_t)row * 16); const f32x4 a = p4[0], b = p4[1], c = p4[2], d = p4[3];
                    const float s = ((a[0] + a[1]) + (a[2] + a[3])) + ((b[0] + b[1]) + (b[2] + b[3])) + ((c[0] + c[1]) + (c[2] + c[3])) + ((d[0] + d[1]) + (d[2] + d[3]));
                    sc = 1.0f / sqrtf(s * (1.0f / 1024.0f) + eps); }
#pragma unroll
                for (int bj = 0; bj < 2; ++bj) { f32x4 v0 = acc[ai][bj][m][0] * sc, v1 = acc[ai][bj][m][1] * sc;
                    if (ACT == 2) {
#pragma unroll
                        for (int e = 0; e < 4; ++e) { const float a0 = fmaxf(v0[e], 0.f), a1 = fmaxf(v1[e], 0.f); v0[e] = a0 * a0; v1[e] = a1 * a1; } }
                    u32x4 w; w.x = cvt_pk_bf16(v0[0], v0[1]); w.y = cvt_pk_bf16(v0[2], v0[3]); w.z = cvt_pk_bf16(v1[0], v1[1]); w.w = cvt_pk_bf16(v1[2], v1[3]);
                    *(u32x4*)(rowp + bj * HALF) = w; } }
    }
};
template <bool XN> struct EpiResid {
    static constexpr bool PERM = false, AFTER_DRAIN = false;
    const float* base; float* out; bf16_t* xn; float* ssq; int ldc;
    __device__ __forceinline__ void operator()(const f32x4 (&acc)[2][2][4][2], const Unit& u, int wr, int wc, int fr, int fq) const {
        typedef unsigned u32x2v __attribute__((ext_vector_type(2)));
        const int row0 = u.pm * BM + wr * 64 + fr; const int col0 = u.pn * BM + wc * 32 + 4 * fq;
#pragma unroll
        for (int ai = 0; ai < 2; ++ai)
#pragma unroll
            for (int m = 0; m < 4; ++m) { const int row = row0 + ai * HALF + m * 16; const size_t off0 = (size_t)row * ldc + col0; float q = 0.f;
#pragma unroll
                for (int bj = 0; bj < 2; ++bj)
#pragma unroll
                    for (int n = 0; n < 2; ++n) { const size_t off = off0 + bj * HALF + n * 16; const f32x4 bs = *(const f32x4*)(base + off); const f32x4 o = bs + acc[ai][bj][m][n];
                        *(f32x4*)(out + off) = o;
                        if (XN) { q += (o[0] * o[0] + o[1] * o[1]) + (o[2] * o[2] + o[3] * o[3]); u32x2v w; w.x = cvt_pk_bf16(o[0], o[1]); w.y = cvt_pk_bf16(o[2], o[3]); *(u32x2v*)(xn + off) = w; } }
                if (XN) { q += __shfl_xor(q, 16); q += __shfl_xor(q, 32); if (fq == 0) ssq[(size_t)row * 16 + u.pn * 4 + wc] = q; }
            }
    }
};
template <class Epi, class Sched, bool ALIGN_EPI = false, bool SP2 = false>
__device__ __forceinline__ void gemm_phase(PG8_LAS unsigned char* lds, const Gemm g, const Sched& S, const Epi& E) {
    const int tid = threadIdx.x, wid = __builtin_amdgcn_readfirstlane(tid >> 6), lane = tid & 63, wr = wid >> 2, wc = wid & 3, fr = lane & 15, fq = lane >> 4;
    const int K = g.K, nt = K / BK;
    unsigned voffA[2], voffB[2];
#pragma unroll
    for (int i = 0; i < 2; ++i) { int R, C; stage_rc(tid * 16 + i * 8192, R, C); const int Rb = Epi::PERM ? ((R & ~31) + perm32(R & 31)) : R;
        voffA[i] = (unsigned)(R * K + C) * 2u; voffB[i] = (unsigned)(Rb * K + C) * 2u; }
    const size_t kstep = (size_t)(BK * 2);
    const size_t hstep = (size_t)HALF * K * 2;
    const size_t tstep = 2 * hstep;
    const unsigned ldsw = (unsigned)wid * 1024u;
    const int aoff = lds_byte(wr * 64 + fr, fq * 8), boff = lds_byte(wc * 32 + fr, fq * 8);
#define PG8_SA(b, h) (((b) * 2 + (h)) * HTB)
#define PG8_SB(b, h) ((4 + (b) * 2 + (h)) * HTB)
#define PG8_STAGE(bufoff, gbase, voff) do { _Pragma("unroll") for (int _i = 0; _i < 2; ++_i) \
        __builtin_amdgcn_global_load_lds((const unsigned*)((const char*)(gbase) + (voff)[_i]), (PG8_LAS unsigned*)(lds + (bufoff) + ldsw + _i * 8192), 16, 0, 0); } while (0)
#define PG8_LDA(dst, b, h) do { _Pragma("unroll") for (int m = 0; m < 4; ++m) _Pragma("unroll") for (int k = 0; k < 2; ++k) dst[m][k] = *(const PG8_LAS bf16x8*)(lds + PG8_SA(b, h) + aoff + m * 2048 + k * 1024); } while (0)
#define PG8_LDB(dst, b, h) do { _Pragma("unroll") for (int n = 0; n < 2; ++n) _Pragma("unroll") for (int k = 0; k < 2; ++k) dst[n][k] = *(const PG8_LAS bf16x8*)(lds + PG8_SB(b, h) + boff + n * 2048 + k * 1024); } while (0)
#define PG8_MMA(ai, bj, At, Bt) do { __builtin_amdgcn_s_setprio(1); _Pragma("unroll") for (int m = 0; m < 4; ++m) _Pragma("unroll") for (int n = 0; n < 2; ++n) _Pragma("unroll") for (int k = 0; k < 2; ++k) \
        acc[ai][bj][m][n] = __builtin_amdgcn_mfma_f32_16x16x32_bf16(Bt[n][k], At[m][k], acc[ai][bj][m][n], 0, 0, 0); __builtin_amdgcn_s_setprio(0); } while (0)
#define PG8_WAIT_V(n) asm volatile("s_waitcnt vmcnt(" #n ")" ::: "memory")
#define PG8_WAIT_L(n) asm volatile("s_waitcnt lgkmcnt(" #n ")" ::: "memory")
#define PG8_BAR __builtin_amdgcn_s_barrier()
#define PG8_SCHED __builtin_amdgcn_sched_barrier(0)
    Unit cur, nxt; int ui = 0;
    if (!S.next(0, cur)) return;
    f32x4 acc[2][2][4][2];
#pragma unroll
    for (int a = 0; a < 2; ++a)
#pragma unroll
        for (int b = 0; b < 2; ++b)
#pragma unroll
            for (int m = 0; m < 4; ++m)
#pragma unroll
                for (int n = 0; n < 2; ++n) acc[a][b][m][n] = (f32x4){0.f, 0.f, 0.f, 0.f};
    bf16x8 At[4][2], B0[2][2], B1[2][2];
    const char* cA = (const char*)g.A + (size_t)cur.pm * tstep; const char* cB = (const char*)g.Bt + (size_t)cur.pn * tstep;
    S.a_ready(cur);
    if constexpr (SP2) {
        PG8_STAGE(PG8_SB(0, 0), cB, voffB); PG8_STAGE(PG8_SB(0, 1), cB + hstep, voffB); PG8_STAGE(PG8_SA(0, 0), cA, voffA); PG8_STAGE(PG8_SA(0, 1), cA + hstep, voffA);
        if (wr == 1) PG8_BAR;
        PG8_WAIT_V(2); PG8_BAR;
        PG8_STAGE(PG8_SB(1, 0), cB + kstep, voffB); PG8_STAGE(PG8_SA(1, 0), cA + kstep, voffA); PG8_STAGE(PG8_SB(1, 1), cB + hstep + kstep, voffB);
        PG8_WAIT_V(6); PG8_BAR;
    } else {
        PG8_STAGE(PG8_SB(0, 0), cB, voffB); PG8_STAGE(PG8_SA(0, 0), cA, voffA); PG8_STAGE(PG8_SB(0, 1), cB + hstep, voffB); PG8_STAGE(PG8_SA(0, 1), cA + hstep, voffA);
        if (wr == 1) PG8_BAR;
        PG8_WAIT_V(4); PG8_BAR;
        PG8_STAGE(PG8_SB(1, 0), cB + kstep, voffB); PG8_STAGE(PG8_SA(1, 0), cA + kstep, voffA); PG8_STAGE(PG8_SB(1, 1), cB + hstep + kstep, voffB);
        PG8_WAIT_V(6); PG8_BAR;
    }
    for (;;) {
        const bool has_next = S.next(ui + 1, nxt);
        const char* nA = has_next ? (const char*)g.A + (size_t)nxt.pm * tstep : cA; const char* nB = has_next ? (const char*)g.Bt + (size_t)nxt.pn * tstep : cB;
        for (int t = 0; t < nt; t += 2) {
            const bool last = (t == nt - 2);
            const char* a1 = cA + (size_t)(t + 1) * kstep;
            const char* a2 = last ? nA : cA + (size_t)(t + 2) * kstep; const char* b2 = last ? nB : cB + (size_t)(t + 2) * kstep;
            const char* a3 = a2 + kstep; const char* b3 = b2 + kstep;
            if (last && has_next) S.a_ready(nxt);
            if constexpr (SP2) {
            PG8_LDB(B0, 0, 0); PG8_LDB(B1, 0, 1); PG8_SCHED; PG8_LDA(At, 0, 0); PG8_STAGE(PG8_SA(1, 1), a1 + hstep, voffA);
            PG8_WAIT_V(8); PG8_WAIT_L(0); PG8_BAR; PG8_MMA(0, 0, At, B0); PG8_MMA(0, 1, At, B1); PG8_BAR; PG8_SCHED;
            PG8_LDA(At, 0, 1); PG8_STAGE(PG8_SB(0, 0), b2, voffB); PG8_STAGE(PG8_SB(0, 1), b2 + hstep, voffB); PG8_STAGE(PG8_SA(0, 0), a2, voffA);
            PG8_WAIT_V(8); PG8_WAIT_L(0); PG8_BAR; PG8_MMA(1, 0, At, B0); PG8_MMA(1, 1, At, B1); PG8_BAR; PG8_SCHED;
            PG8_LDB(B0, 1, 0); PG8_LDB(B1, 1, 1); PG8_SCHED; PG8_LDA(At, 1, 0); PG8_STAGE(PG8_SA(0, 1), a2 + hstep, voffA);
            PG8_WAIT_V(8); PG8_WAIT_L(0); PG8_BAR; PG8_MMA(0, 0, At, B0); PG8_MMA(0, 1, At, B1); PG8_BAR; PG8_SCHED;
            PG8_LDA(At, 1, 1); PG8_STAGE(PG8_SB(1, 0), b3, voffB); PG8_STAGE(PG8_SB(1, 1), b3 + hstep, voffB); PG8_STAGE(PG8_SA(1, 0), a3, voffA);
            PG8_WAIT_V(8); PG8_WAIT_L(0); PG8_BAR; PG8_MMA(1, 0, At, B0); PG8_MMA(1, 1, At, B1); PG8_BAR; PG8_SCHED;
            } else {
            PG8_LDB(B0, 0, 0); PG8_SCHED; PG8_LDA(At, 0, 0); PG8_STAGE(PG8_SA(1, 1), a1 + hstep, voffA);
            PG8_WAIT_L(8); PG8_BAR; PG8_WAIT_L(0); PG8_MMA(0, 0, At, B0); PG8_BAR; PG8_SCHED;
            PG8_LDB(B1, 0, 1); PG8_STAGE(PG8_SB(0, 0), b2, voffB);
            PG8_BAR; PG8_WAIT_L(0); PG8_MMA(0, 1, At, B1); PG8_BAR;
            PG8_LDA(At, 0, 1); PG8_STAGE(PG8_SA(0, 0), a2, voffA);
            PG8_BAR; PG8_WAIT_L(0); PG8_MMA(1, 0, At, B0); PG8_BAR; PG8_SCHED;
            PG8_STAGE(PG8_SB(0, 1), b2 + hstep, voffB);
            PG8_WAIT_V(6); PG8_BAR; PG8_MMA(1, 1, At, B1); PG8_BAR;
            PG8_LDB(B0, 1, 0); PG8_SCHED; PG8_LDA(At, 1, 0); PG8_STAGE(PG8_SA(0, 1), a2 + hstep, voffA);
            PG8_WAIT_L(8); PG8_BAR; PG8_WAIT_L(0); PG8_MMA(0, 0, At, B0); PG8_BAR; PG8_SCHED;
            PG8_LDB(B1, 1, 1); PG8_STAGE(PG8_SB(1, 0), b3, voffB);
            PG8_BAR; PG8_WAIT_L(0); PG8_MMA(0, 1, At, B1); PG8_BAR;
            PG8_LDA(At, 1, 1); PG8_STAGE(PG8_SA(1, 0), a3, voffA);
            PG8_BAR; PG8_WAIT_L(0); PG8_MMA(1, 0, At, B0); PG8_BAR; PG8_SCHED;
            PG8_STAGE(PG8_SB(1, 1), b3 + hstep, voffB);
            PG8_WAIT_V(6); PG8_BAR; PG8_MMA(1, 1, At, B1); PG8_BAR;
            }
        }
        if constexpr (ALIGN_EPI) { if (wr == 0) PG8_BAR; }
        if constexpr (!Epi::AFTER_DRAIN) { E(acc, cur, wr, wc, fr, fq); S.done(cur); }
        if (!has_next) break;
#pragma unroll
        for (int a = 0; a < 2; ++a)
#pragma unroll
            for (int b = 0; b < 2; ++b)
#pragma unroll
                for (int m = 0; m < 4; ++m)
#pragma unroll
                    for (int n = 0; n < 2; ++n) acc[a][b][m][n] = (f32x4){0.f, 0.f, 0.f, 0.f};
        cur = nxt; cA = nA; cB = nB; ++ui;
        if constexpr (ALIGN_EPI) { if (wr == 1) PG8_BAR; }
    }
    PG8_WAIT_V(0);
    if constexpr (!ALIGN_EPI) { if (wr == 0) PG8_BAR; }
    PG8_BAR;
    if constexpr (Epi::AFTER_DRAIN) { E.fused(acc, cur, wr, wc, fr, fq, lds, wid, lane); S.done(cur); }
#undef PG8_SA
#undef PG8_SB
#undef PG8_STAGE
#undef PG8_LDA
#undef PG8_LDB
#undef PG8_MMA
#undef PG8_WAIT_V
#undef PG8_WAIT_L
#undef PG8_BAR
#undef PG8_SCHED
}
}
#ifndef PG8_SP2
#define PG8_SP2 true
#endif
#ifndef PG8_ALIGN
#define PG8_ALIGN true
#endif
constexpr int NWAVES = 8;
#ifndef MK_N_LAUNCHES
#define MK_N_LAUNCHES 1
#endif
constexpr int N_LAUNCHES = MK_N_LAUNCHES;
constexpr int NPHASES = 11;

constexpr int BATCH = 16, T = 2048, D = 1024, M = BATCH * T;
constexpr int DR = 512, HS = 64, NH = 8, DC = 512, CWID = 31, DIN = 2816, DRIN = 1792, FF = 4096;
constexpr int NLU = 1536, KLU = 256;
constexpr float RMS_EPS = 1e-6f, GN_EPS = 64e-5f, LN_EPS = 1e-5f;

constexpr size_t MiB = 1u << 20;
constexpr size_t WS_CTL = 0, CTL_ZERO_BYTES = 1 * MiB;
constexpr size_t WS_RINV1 = 1 * MiB;
constexpr size_t WS_BONUS = 2 * MiB;
constexpr size_t WS_SSQ2 = 3 * MiB;
constexpr size_t WS_WIN = 6 * MiB, WS_WOUT = 12 * MiB, WS_W1 = 14 * MiB, WS_W2 = 22 * MiB, WS_WCAT = 30 * MiB;
constexpr size_t WS_XB = 32 * MiB;
constexpr size_t WS_P = 96 * MiB;
constexpr size_t WS_K2 = 272 * MiB, WS_KK = 304 * MiB, WS_BV = 336 * MiB;
constexpr size_t WS_WD = 368 * MiB;
constexpr size_t WS_Y = 432 * MiB;
constexpr size_t WS_H = 96 * MiB;
constexpr size_t WS_END = 496 * MiB;
constexpr size_t DO_LU = 0, DO_LA = 96 * MiB;
static_assert(WS_H + (size_t)M * FF * 2 <= WS_Y && WS_Y + (size_t)M * DR * 4 <= WS_END && WS_P + (size_t)M * DIN * 2 <= WS_K2, "ws map");
constexpr int CW_BAR = 4096;

constexpr int RING_OFF = 0, RING_BYTES = 131072;
constexpr int LDSCTL_OFF = RING_BYTES, MISC_OFF = LDSCTL_OFF + 320;
constexpr int LDS_BYTES = 147456;

#define GAS __attribute__((address_space(1)))
#define LAS __attribute__((address_space(3)))
typedef unsigned short bf16;
typedef unsigned v4u __attribute__((ext_vector_type(4)));
typedef unsigned v2u __attribute__((ext_vector_type(2)));
typedef float f32x4 __attribute__((ext_vector_type(4)));
typedef GAS unsigned gu32;
#define RLX_AGENT __ATOMIC_RELAXED, __HIP_MEMORY_SCOPE_AGENT
#define LDS_WAIT() asm volatile("s_waitcnt lgkmcnt(0)" ::: "memory")
#define VM_WAIT() asm volatile("s_waitcnt vmcnt(0)" ::: "memory")
__device__ __forceinline__ unsigned f2bf(float f) { unsigned u = __builtin_bit_cast(unsigned, f); return (u + 0x7fffu + ((u >> 16) & 1u)) >> 16; }
__device__ __forceinline__ unsigned pk2(float lo, float hi) { return f2bf(lo) | (f2bf(hi) << 16); }
__device__ __forceinline__ float bflo(unsigned w) { return __builtin_bit_cast(float, w << 16); }
__device__ __forceinline__ float bfhi(unsigned w) { return __builtin_bit_cast(float, w & 0xffff0000u); }
__device__ __forceinline__ float bf1(bf16 h) { return __builtin_bit_cast(float, (unsigned)h << 16); }
__device__ __forceinline__ float sigmoidf_(float x) { return 1.0f / (1.0f + __expf(-x)); }
#define XB_TMO      128
#define XB_XCNT(j)  (256  + 64 * (j))
#define XB_XSUB(j)  (1280 + 64 * (j))
#define XB_XGEN(j)  (2304 + 64 * (j))
#define XB_TOP      3328
#define XB_TOPGEN   3392
#define XCD_BAR_WORDS 3456
#define XB_SPIN_CAP (1u << 18)

__device__ __forceinline__ unsigned xb_ld(unsigned* p)              { return __hip_atomic_load(p, __ATOMIC_RELAXED, __HIP_MEMORY_SCOPE_AGENT); }
__device__ __forceinline__ unsigned xb_add(unsigned* p, unsigned v) { return __hip_atomic_fetch_add(p, v, __ATOMIC_RELAXED, __HIP_MEMORY_SCOPE_AGENT); }
__device__ __forceinline__ unsigned xb_xcc_id() { return (unsigned)__builtin_amdgcn_s_getreg((3 << 11) | 20) & 0xFu; }
#define XB_SPIN(cond, bar) do { unsigned _sp = 0; while (cond) { __builtin_amdgcn_s_sleep(1); \
    if ((++_sp & 255u) == 0u) { if (xb_ld(&(bar)[XB_TMO])) break; if (_sp > XB_SPIN_CAP) { atomicAdd(&(bar)[XB_TMO], 1u); break; } } } } while (0)

struct XcdBarrier {
    unsigned* bar; unsigned x;
    volatile LAS unsigned* st;
};

__device__ __forceinline__ XcdBarrier xcd_barrier_post(unsigned* bar, volatile LAS unsigned* st) {
    XcdBarrier b; b.bar = bar; b.x = xb_xcc_id(); b.st = st;
    if (threadIdx.x == 0) (void)xb_add(&bar[XB_XCNT(b.x)], 1u);
    return b;
}
__device__ __forceinline__ void xcd_barrier_complete(unsigned* bar, unsigned x, unsigned& nloc, unsigned& nx) {
    const unsigned G = gridDim.x * gridDim.y * gridDim.z;
    unsigned sum, cnt, mine, sp = 0u;
    for (;;) {
        sum = 0u; cnt = 0u; mine = 0u;
#pragma unroll
        for (unsigned j = 0; j < 16; ++j) { const unsigned c = xb_ld(&bar[XB_XCNT(j)]); sum += c; cnt += (c > 0u) ? 1u : 0u; mine = (j == x) ? c : mine; }
        if (sum == G) break;
        __builtin_amdgcn_s_sleep(1);
        if ((++sp & 255u) == 0u) { if (xb_ld(&bar[XB_TMO])) break; if (sp > XB_SPIN_CAP) { atomicAdd(&bar[XB_TMO], 1u); break; } }
    }
    nloc = mine > 0u ? mine : 1u; nx = cnt > 0u ? cnt : 1u;
}

__device__ __forceinline__ void xcd_barrier(const XcdBarrier& b) {
    asm volatile("s_waitcnt vmcnt(0)" ::: "memory");
    __syncthreads();
    if (threadIdx.x == 0) {
        unsigned* bar = b.bar;
        __builtin_amdgcn_s_waitcnt(0);
        unsigned nloc = b.st[0], nx = b.st[1];
        if (nloc == 0u) { xcd_barrier_complete(bar, b.x, nloc, nx); b.st[0] = nloc; b.st[1] = nx; }
        const unsigned old = xb_add(&bar[XB_XSUB(b.x)], 1u);
        const unsigned gen = old / nloc;
        if (old + 1u == (gen + 1u) * nloc) {
            __builtin_amdgcn_fence(__ATOMIC_RELEASE, "agent");
            asm volatile("s_waitcnt vmcnt(0)" ::: "memory");
            const unsigned og = xb_add(&bar[XB_TOP], 1u);
            const unsigned tg = og / nx;
            if (og + 1u == (tg + 1u) * nx) xb_add(&bar[XB_TOPGEN], 1u);
            else XB_SPIN(xb_ld(&bar[XB_TOPGEN]) == tg, bar);
            __builtin_amdgcn_fence(__ATOMIC_ACQUIRE, "agent");
            xb_add(&bar[XB_XGEN(b.x)], 1u);
            asm volatile("s_waitcnt vmcnt(0)" ::: "memory");
        } else {
            XB_SPIN(xb_ld(&bar[XB_XGEN(b.x)]) == gen, bar);
            __builtin_amdgcn_fence(__ATOMIC_ACQUIRE, "agent");
            asm volatile("s_waitcnt vmcnt(0)" ::: "memory");
        }
    }
    __syncthreads();
}
__device__ __forceinline__ float wave_sum(float v) {
#pragma unroll
    for (int o = 1; o < 64; o <<= 1) v += __shfl_xor(v, o);
    return v;
}
__device__ __forceinline__ float sum16(float v) {
    v += __shfl_xor(v, 8); v += __shfl_xor(v, 4); v += __shfl_xor(v, 2); v += __shfl_xor(v, 1);
    return v;
}
__device__ __forceinline__ void p0_transpose_item(const float* W, int K, int N, const float* gain, bf16* WT, LAS float* scr, int item, int lane) {
    const int nblk = N / 32, kb = item / nblk, nb = item % nblk, k0 = 64 * kb, n0 = 32 * nb;
#pragma unroll 8
    for (int i = 0; i < 32; ++i) { const int kk = 2 * i + (lane >> 5); const float gv = gain ? gain[k0 + kk] : 1.0f; scr[kk * 33 + (lane & 31)] = W[(size_t)(k0 + kk) * N + n0 + (lane & 31)] * gv; }
    LDS_WAIT(); asm volatile("" ::: "memory");
    const int c = lane & 7;
#pragma unroll
    for (int j = 0; j < 4; ++j) { const int n = (lane >> 3) + 8 * j; const LAS float* s = scr + (8 * c) * 33 + n;
        v4u o; o.x = pk2(s[0 * 33], s[1 * 33]); o.y = pk2(s[2 * 33], s[3 * 33]); o.z = pk2(s[4 * 33], s[5 * 33]); o.w = pk2(s[6 * 33], s[7 * 33]);
        *(GAS v4u*)(WT + (size_t)(n0 + n) * K + k0 + 8 * c) = o; }
    LDS_WAIT(); asm volatile("" ::: "memory");
}
struct In {
    const float *x, *g_mix, *w_in, *mu, *w0, *wdu, *a0, *wau, *wgu, *k_k, *k_a, *r_k, *lnx_g, *lnx_b, *conv_w, *conv_b, *cln_g, *cln_b, *w_out, *g_mlp, *w_ff1, *w_ff2, *g_fin;
};

__device__ __forceinline__ void p0_prologue(LAS unsigned char* lds, const In& I, unsigned char* ws, int gw, int NGW, int wave, int lane) {
    LAS float* scr = (LAS float*)(lds + RING_OFF + wave * 16384);
    bf16* Win_t = (bf16*)(ws + WS_WIN); bf16* Wout_t = (bf16*)(ws + WS_WOUT); bf16* W1_t = (bf16*)(ws + WS_W1); bf16* W2_t = (bf16*)(ws + WS_W2); bf16* Wcat_t = (bf16*)(ws + WS_WCAT);
    constexpr int I_IN = (D / 64) * (DIN / 32), I_O = (D / 64) * (D / 32), I_1 = (D / 64) * (FF / 32), I_2 = (FF / 64) * (D / 32);
    constexpr int NITEMS = I_IN + I_O + I_1 + I_2;
    for (int it = gw; it < NITEMS; it += NGW) {
        int r = it;
        if (r < I_IN) { p0_transpose_item(I.w_in, D, DIN, I.g_mix, Win_t, scr, r, lane); continue; } r -= I_IN;
        if (r < I_O) { p0_transpose_item(I.w_out, D, D, nullptr, Wout_t, scr, r, lane); continue; } r -= I_O;
        if (r < I_1) { p0_transpose_item(I.w_ff1, D, FF, I.g_mlp, W1_t, scr, r, lane); continue; } r -= I_1;
        p0_transpose_item(I.w_ff2, FF, D, nullptr, W2_t, scr, r, lane);
    }
    for (int idx = gw * 64 + lane; idx < NLU * KLU / 8; idx += NGW * 64) {
        const int n = idx / (KLU / 8), k8 = (idx % (KLU / 8)) * 8, blk = n / 512, nn = n % 512; float v[8];
#pragma unroll
        for (int j = 0; j < 8; ++j) { const int k = k8 + j; float x = 0.f;
            if (blk == 0 && k < 64) x = I.wdu[(size_t)k * 512 + nn];
            if (blk == 1 && k >= 64 && k < 128) x = I.wau[(size_t)(k - 64) * 512 + nn];
            if (blk == 2 && k >= 128) x = I.wgu[(size_t)(k - 128) * 512 + nn];
            v[j] = x; }
        v4u o; o.x = pk2(v[0], v[1]); o.y = pk2(v[2], v[3]); o.z = pk2(v[4], v[5]); o.w = pk2(v[6], v[7]);
        *(GAS v4u*)(Wcat_t + (size_t)n * KLU + k8) = o;
    }
    bf16* XB = (bf16*)(ws + WS_XB); float* rinv1 = (float*)(ws + WS_RINV1);
    for (int m = gw; m < M; m += NGW) {
        const GAS f32x4* xr = (const GAS f32x4*)(I.x + (size_t)m * D) + lane;
        f32x4 v[4]; float s = 0.f;
#pragma unroll
        for (int j = 0; j < 4; ++j) { v[j] = xr[64 * j]; s += (v[j].x * v[j].x + v[j].y * v[j].y) + (v[j].z * v[j].z + v[j].w * v[j].w); }
        const float tot = wave_sum(s);
        GAS unsigned long long* o8 = (GAS unsigned long long*)(XB + (size_t)m * D) + lane;
#pragma unroll
        for (int j = 0; j < 4; ++j) o8[64 * j] = (unsigned long long)pk2(v[j].x, v[j].y) | ((unsigned long long)pk2(v[j].z, v[j].w) << 32);
        if (lane == 0) rinv1[m] = 1.0f / sqrtf(tot * (1.0f / D) + RMS_EPS);
    }
}

__device__ __forceinline__ void p2_lora_act(const bf16* P, const float* mu, bf16* LA, int gtid, int NT) {
    for (int item = gtid; item < M * (KLU / 8); item += NT) {
        const int m = item / (KLU / 8), j8 = (item % (KLU / 8)) * 8, col = 3 * DR + j8;
        const v4u c = *(const GAS v4u*)(P + (size_t)m * DIN + col);
        v4u p = (v4u){0u, 0u, 0u, 0u};
        if ((m % T) != 0) p = *(const GAS v4u*)(P + (size_t)(m - 1) * DIN + col);
        float v[8];
#pragma unroll
        for (int w = 0; w < 4; ++w) { const unsigned cw = c[w], pw = p[w];
            const float c0 = bflo(cw), c1 = bfhi(cw), p0 = bflo(pw), p1 = bfhi(pw);
            v[2 * w] = c0 + (p0 - c0) * mu[col + 2 * w]; v[2 * w + 1] = c1 + (p1 - c1) * mu[col + 2 * w + 1]; }
#pragma unroll
        for (int j = 0; j < 8; ++j) { if (j8 < 64) v[j] = tanhf(v[j]); else if (j8 >= 128) v[j] = sigmoidf_(v[j]); }
        v4u o; o.x = pk2(v[0], v[1]); o.y = pk2(v[2], v[3]); o.z = pk2(v[4], v[5]); o.w = pk2(v[6], v[7]);
        *(GAS v4u*)(LA + (size_t)m * KLU + j8) = o;
    }
}

constexpr int CTT = 16, CHALO = CWID - 1, CROWS = CTT + CHALO;
__device__ __forceinline__ void p2_conv(LAS unsigned char* lds, const bf16* P, const In& I, bf16* YCAT, int vcu, int G, int tid, int wave, int lane) {
    LAS float* Hs = (LAS float*)(lds + RING_OFF);
    LAS float* Cs = (LAS float*)(lds + RING_OFF + CROWS * 512 * 4);
    static_assert(CROWS * 512 * 4 + CTT * 512 * 4 <= RING_BYTES, "conv LDS");
    const int c = tid;
    float cw[CWID];
#pragma unroll
    for (int j = 0; j < CWID; ++j) cw[j] = I.conv_w[j * DC + c];
    const float cb = I.conv_b[c];
    for (int tile = vcu; tile < M / CTT; tile += G) {
        const int m0 = tile * CTT, t0 = m0 % T;
#pragma unroll 2
        for (int i = 0; i < CROWS; ++i) { const int t = t0 - CHALO + i; float h = 0.f;
            if (t >= 0) { const size_t rb = (size_t)(m0 - CHALO + i) * DIN + DRIN; const float a = bf1(P[rb + c]), b = bf1(P[rb + DC + c]); h = a * sigmoidf_(b); }
            Hs[i * 512 + c] = h; }
        __syncthreads();
#pragma unroll 1
        for (int tt = 0; tt < CTT; ++tt) { float acc = cb;
#pragma unroll
            for (int j = 0; j < CWID; ++j) acc += cw[j] * Hs[(tt + j) * 512 + c];
            Cs[tt * 512 + c] = acc; }
        __syncthreads();
#pragma unroll
        for (int q = 0; q < 2; ++q) { const int tt = wave * 2 + q; const LAS f32x4* cp = (const LAS f32x4*)(Cs + tt * 512 + lane * 8);
            const f32x4 a = cp[0], b = cp[1];
            const float mean = wave_sum((a.x + a.y) + (a.z + a.w) + (b.x + b.y) + (b.z + b.w)) * (1.0f / DC);
            const f32x4 da = a - mean, db = b - mean;
            const float var = wave_sum((da.x * da.x + da.y * da.y) + (da.z * da.z + da.w * da.w) + (db.x * db.x + db.y * db.y) + (db.z * db.z + db.w * db.w)) * (1.0f / DC);
            const float rstd = 1.0f / sqrtf(var + LN_EPS);
            const f32x4 g0 = *(const f32x4*)(I.cln_g + lane * 8), g1 = *(const f32x4*)(I.cln_g + lane * 8 + 4), b0 = *(const f32x4*)(I.cln_b + lane * 8), b1 = *(const f32x4*)(I.cln_b + lane * 8 + 4);
            float o[8];
#pragma unroll
            for (int e = 0; e < 4; ++e) { const float h0 = da[e] * rstd * g0[e] + b0[e], h1 = db[e] * rstd * g1[e] + b1[e]; o[e] = h0 * sigmoidf_(h0); o[4 + e] = h1 * sigmoidf_(h1); }
            v4u w; w.x = pk2(o[0], o[1]); w.y = pk2(o[2], o[3]); w.z = pk2(o[4], o[5]); w.w = pk2(o[6], o[7]);
            *(GAS v4u*)(YCAT + (size_t)(m0 + tt) * D + DR + lane * 8) = w; }
        __syncthreads();
    }
}

__device__ __forceinline__ void p4_prep(const bf16* P, const bf16* LU, const In& I, unsigned char* ws, int vcu, int G, int wave, int lane) {
    bf16* K2 = (bf16*)(ws + WS_K2); bf16* KK = (bf16*)(ws + WS_KK); bf16* BV = (bf16*)(ws + WS_BV); float* WD = (float*)(ws + WS_WD); float* BONUS = (float*)(ws + WS_BONUS);
    const int col = wave * 64 + lane;
    const float mu_r = I.mu[col], mu_k = I.mu[DR + col], w0 = I.w0[col], a0 = I.a0[col], kkc = I.k_k[col], kac = I.k_a[col], rkc = I.r_k[col];
    constexpr int U = 4;
    for (int mb = vcu * U; mb < M; mb += G * U) {
        float rc[U], rp[U], kc[U], kp[U], dw[U], da[U];
#pragma unroll
        for (int u = 0; u < U; ++u) { const int m = mb + u; const size_t pb = (size_t)m * DIN; const bool first = (m % T) == 0; const size_t pp = first ? pb : pb - DIN;
            rc[u] = bf1(P[pb + col]); kc[u] = bf1(P[pb + DR + col]);
            rp[u] = bf1(P[pp + col]); kp[u] = bf1(P[pp + DR + col]); if (first) { rp[u] = 0.f; kp[u] = 0.f; }
            dw[u] = bf1(LU[(size_t)m * NLU + col]); da[u] = bf1(LU[(size_t)m * NLU + 512 + col]); }
#pragma unroll
        for (int u = 0; u < U; ++u) { const int m = mb + u;
            const float r = rc[u] + (rp[u] - rc[u]) * mu_r, k = kc[u] + (kp[u] - kc[u]) * mu_k;
            const float z = -(w0 + dw[u]);
            const float sp = fmaxf(z, 0.f) + log1pf(expf(-fabsf(z)));
            const float decay = expf(-expf(-sp - 0.5f));
            const float as = 1.0f / (1.0f + expf(-(a0 + da[u])));
            const float kr = k * kkc;
            const float n2 = wave_sum(kr * kr);
            const float kkn = kr / fmaxf(sqrtf(n2), 1e-12f);
            const float k2 = k * (1.0f + (as - 1.0f) * kac);
            const float bon = wave_sum(r * k2 * rkc);
            const size_t o = (size_t)m * DR + col;
            K2[o] = (bf16)f2bf(k2); KK[o] = (bf16)f2bf(kkn); BV[o] = (bf16)f2bf(kkn * as); WD[o] = decay;
            if (lane == 0) BONUS[(size_t)m * NH + wave] = bon; }
    }
}

constexpr int TC = 32, NCH = T / TC, SBUF = 5 * TC * 64 * 4 + TC * 32 * 4;
__device__ __forceinline__ void p5_scan(LAS unsigned char* lds, const bf16* P, const float* mu, const unsigned char* ws, float* Y, int unit, int tid) {
    static_assert(2 * SBUF <= RING_BYTES, "scan LDS");
    const bf16* K2 = (const bf16*)(ws + WS_K2); const bf16* KK = (const bf16*)(ws + WS_KK); const bf16* BV = (const bf16*)(ws + WS_BV); const float* WD = (const float*)(ws + WS_WD);
    const int bh = unit >> 1, half = unit & 1, b = bh >> 3, h = bh & 7;
    const int rowl = tid >> 4, seg = tid & 15;
    const int si = tid >> 4, se = (tid & 15) * 4;
    const int vi = (tid & 255) >> 3, vj = (tid & 7) * 4;
    const f32x4 mur = *(const f32x4*)(mu + h * 64 + se);
    const f32x4 muv = *(const f32x4*)(mu + 2 * DR + h * 64 + half * 32 + vj);
    const size_t mrow0 = (size_t)b * T;
    v2u gk2, gkk, gbv, gr, grp, gv, gvp; f32x4 gw;
    auto issue = [&](int c) {
        const int t = c * TC + si; const size_t m = mrow0 + t; const size_t o = m * DR + h * 64 + se;
        gk2 = *(const GAS v2u*)(K2 + o); gkk = *(const GAS v2u*)(KK + o); gbv = *(const GAS v2u*)(BV + o); gw = *(const GAS f32x4*)(WD + o);
        gr = *(const GAS v2u*)(P + m * DIN + h * 64 + se);
        grp = (v2u){0u, 0u}; if (t > 0) grp = *(const GAS v2u*)(P + (m - 1) * DIN + h * 64 + se);
        if (tid < 256) { const int tv = c * TC + vi; const size_t mv = mrow0 + tv; const size_t ov = mv * DIN + 2 * DR + h * 64 + half * 32 + vj;
            gv = *(const GAS v2u*)(P + ov); gvp = (v2u){0u, 0u}; if (tv > 0) gvp = *(const GAS v2u*)(P + ov - DIN); }
    };
    auto commit = [&](int p) {
        LAS unsigned char* bp = lds + RING_OFF + p * SBUF;
        LAS f32x4* R4 = (LAS f32x4*)(bp); LAS f32x4* W4 = (LAS f32x4*)(bp + 8192); LAS f32x4* K4 = (LAS f32x4*)(bp + 16384); LAS f32x4* Q4 = (LAS f32x4*)(bp + 24576); LAS f32x4* B4 = (LAS f32x4*)(bp + 32768);
        LAS f32x4* V4 = (LAS f32x4*)(bp + 40960);
        const int idx = si * 16 + (tid & 15);
        f32x4 rc = (f32x4){bflo(gr.x), bfhi(gr.x), bflo(gr.y), bfhi(gr.y)}, rp = (f32x4){bflo(grp.x), bfhi(grp.x), bflo(grp.y), bfhi(grp.y)};
        R4[idx] = rc + (rp - rc) * mur;
        W4[idx] = gw;
        K4[idx] = (f32x4){bflo(gk2.x), bfhi(gk2.x), bflo(gk2.y), bfhi(gk2.y)};
        Q4[idx] = (f32x4){bflo(gkk.x), bfhi(gkk.x), bflo(gkk.y), bfhi(gkk.y)};
        B4[idx] = (f32x4){bflo(gbv.x), bfhi(gbv.x), bflo(gbv.y), bfhi(gbv.y)};
        if (tid < 256) { f32x4 vc = (f32x4){bflo(gv.x), bfhi(gv.x), bflo(gv.y), bfhi(gv.y)}, vp = (f32x4){bflo(gvp.x), bfhi(gvp.x), bflo(gvp.y), bfhi(gvp.y)};
            V4[vi * 8 + (tid & 7)] = vc + (vp - vc) * muv; }
    };
    float s0 = 0.f, s1 = 0.f, s2 = 0.f, s3 = 0.f;
    issue(0); commit(0); __syncthreads();
    float* yout = Y + mrow0 * DR + h * 64 + half * 32 + rowl;
    for (int c = 0; c < NCH; ++c) {
        if (c + 1 < NCH) issue(c + 1);
        const LAS unsigned char* bp = lds + RING_OFF + (c & 1) * SBUF;
        const LAS f32x4* R4 = (const LAS f32x4*)(bp); const LAS f32x4* W4 = (const LAS f32x4*)(bp + 8192); const LAS f32x4* K4 = (const LAS f32x4*)(bp + 16384); const LAS f32x4* Q4 = (const LAS f32x4*)(bp + 24576); const LAS f32x4* B4 = (const LAS f32x4*)(bp + 32768);
        const LAS float* V1 = (const LAS float*)(bp + 40960);
#pragma unroll 4
        for (int i = 0; i < TC; ++i) {
            const f32x4 q = Q4[i * 16 + seg], w = W4[i * 16 + seg], bb = B4[i * 16 + seg], kk = K4[i * 16 + seg], r = R4[i * 16 + seg]; const float v = V1[i * 32 + rowl];
            const float sk = sum16((s0 * q.x + s1 * q.y) + (s2 * q.z + s3 * q.w));
            s0 = s0 * w.x - sk * bb.x + v * kk.x; s1 = s1 * w.y - sk * bb.y + v * kk.y; s2 = s2 * w.z - sk * bb.z + v * kk.z; s3 = s3 * w.w - sk * bb.w + v * kk.w;
            const float yp = sum16((s0 * r.x + s1 * r.y) + (s2 * r.z + s3 * r.w));
            if (seg == 0) yout[(size_t)(c * TC + i) * DR] = yp;
        }
        if (c + 1 < NCH) commit((c + 1) & 1);
        __syncthreads();
    }
}

__device__ __forceinline__ void p6_post(const bf16* P, const bf16* LU, const In& I, const unsigned char* ws, bf16* YCAT, int vcu, int G, int wave, int lane) {
    const float* Y = (const float*)(ws + WS_Y); const float* BONUS = (const float*)(ws + WS_BONUS);
    const int col = wave * 64 + lane;
    const float mu_v = I.mu[2 * DR + col], lg = I.lnx_g[col], lb = I.lnx_b[col];
    constexpr int U = 4;
    for (int mb = vcu * U; mb < M; mb += G * U) {
        float y[U], vc[U], vp[U], g[U], bo[U];
#pragma unroll
        for (int u = 0; u < U; ++u) { const int m = mb + u; const size_t pb = (size_t)m * DIN + 2 * DR + col; const bool first = (m % T) == 0;
            y[u] = Y[(size_t)m * DR + col]; vc[u] = bf1(P[pb]); vp[u] = first ? 0.f : bf1(P[pb - DIN]); g[u] = bf1(LU[(size_t)m * NLU + 1024 + col]); bo[u] = BONUS[(size_t)m * NH + wave]; }
#pragma unroll
        for (int u = 0; u < U; ++u) { const int m = mb + u;
            const float mean = wave_sum(y[u]) * (1.0f / HS); const float d = y[u] - mean; const float var = wave_sum(d * d) * (1.0f / HS);
            const float yn = d * (1.0f / sqrtf(var + GN_EPS)) * lg + lb;
            const float v = vc[u] + (vp[u] - vc[u]) * mu_v;
            YCAT[(size_t)m * D + col] = (bf16)f2bf((yn + bo[u] * v) * g[u]); }
    }
}

__device__ __forceinline__ void p10_final(float* out, const float* gfin, int gw, int NGW, int lane) {
    f32x4 gv[4];
#pragma unroll
    for (int j = 0; j < 4; ++j) gv[j] = *(const f32x4*)(gfin + 4 * lane + 256 * j);
    for (int m = gw; m < M; m += NGW) {
        GAS f32x4* xr = (GAS f32x4*)(out + (size_t)m * D) + lane;
        f32x4 v[4]; float s = 0.f;
#pragma unroll
        for (int j = 0; j < 4; ++j) { v[j] = xr[64 * j]; s += (v[j].x * v[j].x + v[j].y * v[j].y) + (v[j].z * v[j].z + v[j].w * v[j].w); }
        const float rinv = 1.0f / sqrtf(wave_sum(s) * (1.0f / D) + RMS_EPS);
#pragma unroll
        for (int j = 0; j < 4; ++j) xr[64 * j] = v[j] * rinv * gv[j];
    }
}
struct Args { const float* in[23]; float* out; unsigned char* ws; int ph_lo, ph_hi, li, pad; };
template <int LO, int HI> __global__ void __launch_bounds__(NWAVES * 64, 2) hymba_fwd(Args args) {
    extern __shared__ __attribute__((aligned(16))) unsigned char lds_raw[];
    LAS unsigned char* lds = (LAS unsigned char*)lds_raw;
    volatile LAS unsigned* MISC = (volatile LAS unsigned*)(lds + MISC_OFF);
    const int tid = threadIdx.x, lane = tid & 63, wave = __builtin_amdgcn_readfirstlane(tid >> 6);
    const int G = gridDim.x; const int bx = blockIdx.x; const int vcu = (G % 8 == 0) ? (bx % 8) * (G / 8) + bx / 8 : bx;
    const int gw = vcu * NWAVES + wave, NGW = G * NWAVES, gtid = vcu * (NWAVES * 64) + tid, NT = G * NWAVES * 64;
    unsigned char* ws = args.ws;
    gu32* ctl = (gu32*)(ws + WS_CTL);
    In I; I.x = args.in[0]; I.g_mix = args.in[1]; I.w_in = args.in[2]; I.mu = args.in[3]; I.w0 = args.in[4]; I.wdu = args.in[5]; I.a0 = args.in[6]; I.wau = args.in[7]; I.wgu = args.in[8];
    I.k_k = args.in[9]; I.k_a = args.in[10]; I.r_k = args.in[11]; I.lnx_g = args.in[12]; I.lnx_b = args.in[13]; I.conv_w = args.in[14]; I.conv_b = args.in[15]; I.cln_g = args.in[16]; I.cln_b = args.in[17];
    I.w_out = args.in[18]; I.g_mlp = args.in[19]; I.w_ff1 = args.in[20]; I.w_ff2 = args.in[21]; I.g_fin = args.in[22];
    float* out = args.out;
    bf16* Win_t = (bf16*)(ws + WS_WIN); bf16* Wout_t = (bf16*)(ws + WS_WOUT); bf16* W1_t = (bf16*)(ws + WS_W1); bf16* W2_t = (bf16*)(ws + WS_W2); bf16* Wcat_t = (bf16*)(ws + WS_WCAT);
    bf16* XB = (bf16*)(ws + WS_XB); bf16* YCAT = (bf16*)(ws + WS_XB); bf16* P = (bf16*)(ws + WS_P); bf16* XN2 = (bf16*)(ws + WS_Y); bf16* HB = (bf16*)(ws + WS_H);
    bf16* LU = (bf16*)((unsigned char*)out + DO_LU); bf16* LA = (bf16*)((unsigned char*)out + DO_LA);
    float* rinv1 = (float*)(ws + WS_RINV1); float* ssq2 = (float*)(ws + WS_SSQ2);

    for (int u = tid; u < (LDS_BYTES - LDSCTL_OFF) / 4; u += NWAVES * 64) ((LAS unsigned*)(lds + LDSCTL_OFF))[u] = 0u;
    __syncthreads();
    XcdBarrier bar; bar.bar = (unsigned*)(ctl + CW_BAR); bar.x = 0; bar.st = nullptr;
    if (HI - LO > 1) bar = xcd_barrier_post((unsigned*)(ctl + CW_BAR), MISC + 8);
#define GRID_BAR() do { if (HI - LO > 1) xcd_barrier(bar); } while (0)
#define IN(k) (LO <= (k) && (k) < HI)
#define BOTH(k) (IN(k) && IN((k) + 1))

    if (IN(0)) { p0_prologue(lds, I, ws, gw, NGW, wave, lane); if (BOTH(0)) GRID_BAR(); }
    if (IN(1)) {
        pg8::Gemm g{XB, Win_t, M, DIN, D}; pg8::StaticOrder S; S.init(M, DIN, G, bx);
        pg8::EpiBf16RS<0, 1> E{P, DIN, rinv1, 0.f};
        pg8::gemm_phase<pg8::EpiBf16RS<0, 1>, pg8::StaticOrder, PG8_ALIGN, PG8_SP2>(lds + RING_OFF, g, S, E);
        if (BOTH(1)) GRID_BAR();
    }
    if (IN(2)) { p2_lora_act(P, I.mu, LA, gtid, NT); p2_conv(lds, P, I, YCAT, vcu, G, tid, wave, lane); if (BOTH(2)) GRID_BAR(); }
    if (IN(3)) {
        int kq = KLU; asm volatile("" : "+s"(kq));
        pg8::Gemm g{LA, Wcat_t, M, NLU, kq}; pg8::StaticOrder S; S.init(M, NLU, G, bx);
        pg8::EpiBf16RS<0, 0> E{LU, NLU, nullptr, 0.f};
        pg8::gemm_phase<pg8::EpiBf16RS<0, 0>, pg8::StaticOrder, PG8_ALIGN, PG8_SP2>(lds + RING_OFF, g, S, E);
        if (BOTH(3)) GRID_BAR();
    }
    if (IN(4)) { p4_prep(P, LU, I, ws, vcu, G, wave, lane); if (BOTH(4)) GRID_BAR(); }
    if (IN(5)) { for (int unit = vcu; unit < BATCH * NH * 2; unit += G) p5_scan(lds, P, I.mu, ws, (float*)(ws + WS_Y), unit, tid); if (BOTH(5)) GRID_BAR(); }
    if (IN(6)) { p6_post(P, LU, I, ws, YCAT, vcu, G, wave, lane); if (BOTH(6)) GRID_BAR(); }
    if (IN(7)) {
        pg8::Gemm g{YCAT, Wout_t, M, D, D}; pg8::StaticOrder S; S.init(M, D, G, bx);
        pg8::EpiResid<true> E{I.x, out, XN2, ssq2, D};
        pg8::gemm_phase<pg8::EpiResid<true>, pg8::StaticOrder, PG8_ALIGN, PG8_SP2>(lds + RING_OFF, g, S, E);
        if (BOTH(7)) GRID_BAR();
    }
    if (IN(8)) {
        pg8::Gemm g{XN2, W1_t, M, FF, D}; pg8::StaticOrder S; S.init(M, FF, G, bx);
        pg8::EpiBf16RS<2, 2> E{HB, FF, ssq2, RMS_EPS};
        pg8::gemm_phase<pg8::EpiBf16RS<2, 2>, pg8::StaticOrder, PG8_ALIGN, PG8_SP2>(lds + RING_OFF, g, S, E);
        if (BOTH(8)) GRID_BAR();
    }
    if (IN(9)) {
        pg8::Gemm g{HB, W2_t, M, D, FF}; pg8::StaticOrder S; S.init(M, D, G, bx);
        pg8::EpiResid<false> E{out, out, nullptr, nullptr, D};
        pg8::gemm_phase<pg8::EpiResid<false>, pg8::StaticOrder, PG8_ALIGN, PG8_SP2>(lds + RING_OFF, g, S, E);
        if (BOTH(9)) GRID_BAR();
    }
    if (IN(10)) { p10_final(out, I.g_fin, gw, NGW, lane); }
#undef IN
#undef BOTH
}

#if MK_N_LAUNCHES == 1
static hipError_t set_attr_all(hipFuncAttribute at, int v) { return hipFuncSetAttribute((const void*)hymba_fwd<0, NPHASES>, at, v); }
template <int K> static void launch_phases(int, hipStream_t, Args&) {}
#define OCC_KERNEL hymba_fwd<0, NPHASES>
#else
template <int K> static hipError_t set_attr_k(hipFuncAttribute at, int v) { hipError_t e = hipFuncSetAttribute((const void*)hymba_fwd<K, K + 1>, at, v); if (e != hipSuccess) return e; if constexpr (K + 1 < NPHASES) return set_attr_k<K + 1>(at, v); else return hipSuccess; }
static hipError_t set_attr_all(hipFuncAttribute at, int v) { return set_attr_k<0>(at, v); }
#define OCC_KERNEL hymba_fwd<1, 2>
template <int K> static void launch_phases(int grid, hipStream_t stream, Args& a) {
    a.ph_lo = K; a.ph_hi = K + 1; a.li = K;
    hipLaunchKernelGGL((hymba_fwd<K, K + 1>), dim3(grid), dim3(NWAVES * 64), LDS_BYTES, stream, a);
    if constexpr (K + 1 < NPHASES) launch_phases<K + 1>(grid, stream, a);
}
#endif
extern "C" void kernel_launch(void* const* d_in, const int* in_sizes, int n_in, void* d_out, int out_size, void* d_ws, size_t ws_size, hipStream_t stream) {
    static int grid = 0;
    if (grid == 0) {
        if (n_in != 23 || in_sizes[0] != M * D || out_size != M * D || ws_size < WS_END) { fprintf(stderr, "kernel_launch: unexpected shapes: n_in %d in0 %d out %d ws %zu; nothing launched\n", n_in, n_in > 0 ? in_sizes[0] : -1, out_size, ws_size); grid = -1; return; }
        int dev = 0, cus = 0, per_cu = 0;
        if (hipGetDevice(&dev) != hipSuccess || hipDeviceGetAttribute(&cus, hipDeviceAttributeMultiprocessorCount, dev) != hipSuccess) { grid = -1; return; }
        if (set_attr_all( hipFuncAttributeMaxDynamicSharedMemorySize, LDS_BYTES) != hipSuccess) { fprintf(stderr, "kernel_launch: hipFuncSetAttribute failed\n"); grid = -1; return; }
        if (hipOccupancyMaxActiveBlocksPerMultiprocessor(&per_cu, (const void*)OCC_KERNEL, NWAVES * 64, LDS_BYTES) != hipSuccess || per_cu < 1) { fprintf(stderr, "kernel_launch: occupancy query reports %d\n", per_cu); per_cu = 1; }
        (void)hipGetLastError();
        grid = cus;
    }
    if (grid < 0) return;
    if (hipMemsetAsync((char*)d_ws + WS_CTL, 0, CTL_ZERO_BYTES, stream) != hipSuccess) { fprintf(stderr, "kernel_launch: memset failed\n"); return; }
    Args a{};
    for (int i = 0; i < 23; ++i) a.in[i] = (const float*)d_in[i];
    a.out = (float*)d_out; a.ws = (unsigned char*)d_ws;
    if (N_LAUNCHES == 1) {
        a.ph_lo = 0; a.ph_hi = NPHASES; a.li = 0;
#if MK_N_LAUNCHES == 1
        hipLaunchKernelGGL((hymba_fwd<0, NPHASES>), dim3(grid), dim3(NWAVES * 64), LDS_BYTES, stream, a);
#endif
    } else {
        launch_phases<0>(grid, stream, a);
    }
    const hipError_t le = hipPeekAtLastError();
    if (le != hipSuccess) fprintf(stderr, "kernel_launch: launch failed: %s\n", hipGetErrorName(le));
}
```

```cpp
#include <hip/hip_runtime.h>
#include <cstdio>
#include <cstdint>
#define MK_N_LAUNCHES 1
namespace pg8 {
#define PG8_LAS __attribute__((address_space(3)))
typedef unsigned short bf16_t;
typedef short bf16x8 __attribute__((ext_vector_type(8)));
typedef float f32x4 __attribute__((ext_vector_type(4)));
typedef unsigned u32x4 __attribute__((ext_vector_type(4)));
constexpr int BM = 256, BK = 64, HALF = 128, HTB = HALF * BK * 2  , STAGE_BYTES = 8 * HTB, NXCD = 8, WGM = 8;

__host__ __device__ __forceinline__ int lds_byte(int r, int c) { const int st = (r >> 4) * 2 + (c >> 5), rr = r & 15, cc = c & 31, ob = rr * 64 + cc * 2; return st * 1024 + (ob ^ (((ob >> 9) & 1) << 5)); }
__host__ __device__ __forceinline__ void stage_rc(int b, int& R, int& C) { const int st = b / 1024, sb = b % 1024, swz = sb ^ (((sb >> 9) & 1) << 5); R = (st >> 1) * 16 + swz / 64; C = (st & 1) * 32 + (swz % 64) / 2; }
__host__ __device__ __forceinline__ int perm32(int rho) { const int n = rho >> 4, i = rho & 15; return 8 * (i >> 2) + 4 * n + (i & 3); }

struct Unit { int pm, pn; };
struct Gemm { const bf16_t* A; const bf16_t* Bt; int M, N, K; };

struct StaticOrder {
    int nM, nN, nwg, G, c;
    __host__ __device__ void init(int M, int N, int G_, int c_) { nM = M / BM; nN = N / BM; nwg = nM * nN; G = G_; c = c_; }
    __host__ __device__ bool next(int i, Unit& u) const {
        const long L = (long)i * G + c; if (L >= nwg) return false;
        int wgid = (int)L; { const int q = nwg / NXCD, r = nwg % NXCD, xcd = wgid % NXCD, off = wgid / NXCD; wgid = (xcd < r ? xcd * (q + 1) : r * (q + 1) + (xcd - r) * q) + off; }
        const int nig = WGM * nN, gid = wgid / nig, fm = gid * WGM, gsz = (nM - fm) < WGM ? (nM - fm) : WGM;
        u.pm = fm + ((wgid % nig) % gsz); u.pn = (wgid % nig) / gsz; return true;
    }
    __device__ __forceinline__ void a_ready(const Unit&) const {}
    __device__ __forceinline__ void done(const Unit&) const {}
};

__device__ __forceinline__ unsigned cvt_pk_bf16(float lo, float hi) { unsigned r; asm volatile("v_cvt_pk_bf16_f32 %0, %1, %2" : "=v"(r) : "v"(lo), "v"(hi)); return r; }
typedef float f32x2 __attribute__((ext_vector_type(2)));
template <int ACT, int RS> struct EpiBf16RS {
    static constexpr bool PERM = true, AFTER_DRAIN = false;
    bf16_t* O; int ldc; const float* rs; float eps;
    __device__ __forceinline__ void operator()(const f32x4 (&acc)[2][2][4][2], const Unit& u, int wr, int wc, int fr, int fq) const {
        const int row0 = u.pm * BM + wr * 64 + fr; const int col0 = u.pn * BM + wc * 32 + 8 * fq;
#pragma unroll
        for (int ai = 0; ai < 2; ++ai)
#pragma unroll
            for (int m = 0; m < 4; ++m) { const int row = row0 + ai * HALF + m * 16; bf16_t* rowp = O + (size_t)row * ldc + col0;
                float sc = 1.f;
                if (RS == 1) sc = rs[row];
                if (RS == 2) { const f32x4* p4 = (const f32x4*)(rs + (size_t)row * 16); const f32x4 a = p4[0], b = p4[1], c = p4[2], d = p4[3];
                    const float s = ((a[0] + a[1]) + (a[2] + a[3])) + ((b[0] + b[1]) + (b[2] + b[3])) + ((c[0] + c[1]) + (c[2] + c[3])) + ((d[0] + d[1]) + (d[2] + d[3]));
                    sc = 1.0f / sqrtf(s * (1.0f / 1024.0f) + eps); }
#pragma unroll
                for (int bj = 0; bj < 2; ++bj) { f32x4 v0 = acc[ai][bj][m][0] * sc, v1 = acc[ai][bj][m][1] * sc;
                    if (ACT == 2) {
#pragma unroll
                        for (int e = 0; e < 4; ++e) { const float a0 = fmaxf(v0[e], 0.f), a1 = fmaxf(v1[e], 0.f); v0[e] = a0 * a0; v1[e] = a1 * a1; } }
                    u32x4 w; w.x = cvt_pk_bf16(v0[0], v0[1]); w.y = cvt_pk_bf16(v0[2], v0[3]); w.z = cvt_pk_bf16(v1[0], v1[1]); w.w = cvt_pk_bf16(v1[2], v1[3]);
                    *(u32x4*)(rowp + bj * HALF) = w; } }
    }
};
template <bool XN> struct EpiResid {
    static constexpr bool PERM = false, AFTER_DRAIN = false;
    const float* base; float* out; bf16_t* xn; float* ssq; int ldc;
    __device__ __forceinline__ void operator()(const f32x4 (&acc)[2][2][4][2], const Unit& u, int wr, int wc, int fr, int fq) const {
        typedef unsigned u32x2v __attribute__((ext_vector_type(2)));
        const int row0 = u.pm * BM + wr * 64 + fr; const int col0 = u.pn * BM + wc * 32 + 4 * fq;
#pragma unroll
        for (int ai = 0; ai < 2; ++ai)
#pragma unroll
            for (int m = 0; m < 4; ++m) { const int row = row0 + ai * HALF + m * 16; const size_t off0 = (size_t)row * ldc + col0; float q = 0.f;
#pragma unroll
                for (int bj = 0; bj < 2; ++bj)
#pragma unroll
                    for (int n = 0; n < 2; ++n) { const size_t off = off0 + bj * HALF + n * 16; const f32x4 bs = *(const f32x4*)(base + off); const f32x4 o = bs + acc[ai][bj][m][n];
                        *(f32x4*)(out + off) = o;
                        if (XN) { q += (o[0] * o[0] + o[1] * o[1]) + (o[2] * o[2] + o[3] * o[3]); u32x2v w; w.x = cvt_pk_bf16(o[0], o[1]); w.y = cvt_pk_bf16(o[2], o[3]); *(u32x2v*)(xn + off) = w; } }
                if (XN) { q += __shfl_xor(q, 16); q += __shfl_xor(q, 32); if (fq == 0) ssq[(size_t)row * 16 + u.pn * 4 + wc] = q; }
            }
    }
};
template <class Epi, class Sched, bool ALIGN_EPI = false, bool SP2 = false>
__device__ __forceinline__ void gemm_phase(PG8_LAS unsigned char* lds, const Gemm g, const Sched& S, const Epi& E) {
    const int tid = threadIdx.x, wid = __builtin_amdgcn_readfirstlane(tid >> 6), lane = tid & 63, wr = wid >> 2, wc = wid & 3, fr = lane & 15, fq = lane >> 4;
    const int K = g.K, nt = K / BK;
    unsigned voffA[2], voffB[2];
#pragma unroll
    for (int i = 0; i < 2; ++i) { int R, C; stage_rc(tid * 16 + i * 8192, R, C); const int Rb = Epi::PERM ? ((R & ~31) + perm32(R & 31)) : R;
        voffA[i] = (unsigned)(R * K + C) * 2u; voffB[i] = (unsigned)(Rb * K + C) * 2u; }
    const size_t kstep = (size_t)(BK * 2);
    const size_t hstep = (size_t)HALF * K * 2;
    const size_t tstep = 2 * hstep;
    const unsigned ldsw = (unsigned)wid * 1024u;
    const int aoff = lds_byte(wr * 64 + fr, fq * 8), boff = lds_byte(wc * 32 + fr, fq * 8);
#define PG8_SA(b, h) (((b) * 2 + (h)) * HTB)
#define PG8_SB(b, h) ((4 + (b) * 2 + (h)) * HTB)
#define PG8_STAGE(bufoff, gbase, voff) do { _Pragma("unroll") for (int _i = 0; _i < 2; ++_i) \
        __builtin_amdgcn_global_load_lds((const unsigned*)((const char*)(gbase) + (voff)[_i]), (PG8_LAS unsigned*)(lds + (bufoff) + ldsw + _i * 8192), 16, 0, 0); } while (0)
#define PG8_LDA(dst, b, h) do { _Pragma("unroll") for (int m = 0; m < 4; ++m) _Pragma("unroll") for (int k = 0; k < 2; ++k) dst[m][k] = *(const PG8_LAS bf16x8*)(lds + PG8_SA(b, h) + aoff + m * 2048 + k * 1024); } while (0)
#define PG8_LDB(dst, b, h) do { _Pragma("unroll") for (int n = 0; n < 2; ++n) _Pragma("unroll") for (int k = 0; k < 2; ++k) dst[n][k] = *(const PG8_LAS bf16x8*)(lds + PG8_SB(b, h) + boff + n * 2048 + k * 1024); } while (0)
#define PG8_MMA(ai, bj, At, Bt) do { __builtin_amdgcn_s_setprio(1); _Pragma("unroll") for (int m = 0; m < 4; ++m) _Pragma("unroll") for (int n = 0; n < 2; ++n) _Pragma("unroll") for (int k = 0; k < 2; ++k) \
        acc[ai][bj][m][n] = __builtin_amdgcn_mfma_f32_16x16x32_bf16(Bt[n][k], At[m][k], acc[ai][bj][m][n], 0, 0, 0); __builtin_amdgcn_s_setprio(0); } while (0)
#define PG8_WAIT_V(n) asm volatile("s_waitcnt vmcnt(" #n ")" ::: "memory")
#define PG8_WAIT_L(n) asm volatile("s_waitcnt lgkmcnt(" #n ")" ::: "memory")
#define PG8_BAR __builtin_amdgcn_s_barrier()
#define PG8_SCHED __builtin_amdgcn_sched_barrier(0)
    Unit cur, nxt; int ui = 0;
    if (!S.next(0, cur)) return;
    f32x4 acc[2][2][4][2];
#pragma unroll
    for (int a = 0; a < 2; ++a)
#pragma unroll
        for (int b = 0; b < 2; ++b)
#pragma unroll
            for (int m = 0; m < 4; ++m)
#pragma unroll
                for (int n = 0; n < 2; ++n) acc[a][b][m][n] = (f32x4){0.f, 0.f, 0.f, 0.f};
    bf16x8 At[4][2], B0[2][2], B1[2][2];
    const char* cA = (const char*)g.A + (size_t)cur.pm * tstep; const char* cB = (const char*)g.Bt + (size_t)cur.pn * tstep;
    S.a_ready(cur);
    if constexpr (SP2) {
        PG8_STAGE(PG8_SB(0, 0), cB, voffB); PG8_STAGE(PG8_SB(0, 1), cB + hstep, voffB); PG8_STAGE(PG8_SA(0, 0), cA, voffA); PG8_STAGE(PG8_SA(0, 1), cA + hstep, voffA);
        if (wr == 1) PG8_BAR;
        PG8_WAIT_V(2); PG8_BAR;
        PG8_STAGE(PG8_SB(1, 0), cB + kstep, voffB); PG8_STAGE(PG8_SA(1, 0), cA + kstep, voffA); PG8_STAGE(PG8_SB(1, 1), cB + hstep + kstep, voffB);
        PG8_WAIT_V(6); PG8_BAR;
    } else {
        PG8_STAGE(PG8_SB(0, 0), cB, voffB); PG8_STAGE(PG8_SA(0, 0), cA, voffA); PG8_STAGE(PG8_SB(0, 1), cB + hstep, voffB); PG8_STAGE(PG8_SA(0, 1), cA + hstep, voffA);
        if (wr == 1) PG8_BAR;
        PG8_WAIT_V(4); PG8_BAR;
        PG8_STAGE(PG8_SB(1, 0), cB + kstep, voffB); PG8_STAGE(PG8_SA(1, 0), cA + kstep, voffA); PG8_STAGE(PG8_SB(1, 1), cB + hstep + kstep, voffB);
        PG8_WAIT_V(6); PG8_BAR;
    }
    for (;;) {
        const bool has_next = S.next(ui + 1, nxt);
        const char* nA = has_next ? (const char*)g.A + (size_t)nxt.pm * tstep : cA; const char* nB = has_next ? (const char*)g.Bt + (size_t)nxt.pn * tstep : cB;
        for (int t = 0; t < nt; t += 2) {
            const bool last = (t == nt - 2);
            const char* a1 = cA + (size_t)(t + 1) * kstep;
            const char* a2 = last ? nA : cA + (size_t)(t + 2) * kstep; const char* b2 = last ? nB : cB + (size_t)(t + 2) * kstep;
            const char* a3 = a2 + kstep; const char* b3 = b2 + kstep;
            if (last && has_next) S.a_ready(nxt);
            if constexpr (SP2) {
            PG8_LDB(B0, 0, 0); PG8_LDB(B1, 0, 1); PG8_SCHED; PG8_LDA(At, 0, 0); PG8_STAGE(PG8_SA(1, 1), a1 + hstep, voffA);
            PG8_WAIT_V(8); PG8_WAIT_L(0); PG8_BAR; PG8_MMA(0, 0, At, B0); PG8_MMA(0, 1, At, B1); PG8_BAR; PG8_SCHED;
            PG8_LDA(At, 0, 1); PG8_STAGE(PG8_SB(0, 0), b2, voffB); PG8_STAGE(PG8_SB(0, 1), b2 + hstep, voffB); PG8_STAGE(PG8_SA(0, 0), a2, voffA);
            PG8_WAIT_V(8); PG8_WAIT_L(0); PG8_BAR; PG8_MMA(1, 0, At, B0); PG8_MMA(1, 1, At, B1); PG8_BAR; PG8_SCHED;
            PG8_LDB(B0, 1, 0); PG8_LDB(B1, 1, 1); PG8_SCHED; PG8_LDA(At, 1, 0); PG8_STAGE(PG8_SA(0, 1), a2 + hstep, voffA);
            PG8_WAIT_V(8); PG8_WAIT_L(0); PG8_BAR; PG8_MMA(0, 0, At, B0); PG8_MMA(0, 1, At, B1); PG8_BAR; PG8_SCHED;
            PG8_LDA(At, 1, 1); PG8_STAGE(PG8_SB(1, 0), b3, voffB); PG8_STAGE(PG8_SB(1, 1), b3 + hstep, voffB); PG8_STAGE(PG8_SA(1, 0), a3, voffA);
            PG8_WAIT_V(8); PG8_WAIT_L(0); PG8_BAR; PG8_MMA(1, 0, At, B0); PG8_MMA(1, 1, At, B1); PG8_BAR; PG8_SCHED;
            } else {
            PG8_LDB(B0, 0, 0); PG8_SCHED; PG8_LDA(At, 0, 0); PG8_STAGE(PG8_SA(1, 1), a1 + hstep, voffA);
            PG8_WAIT_L(8); PG8_BAR; PG8_WAIT_L(0); PG8_MMA(0, 0, At, B0); PG8_BAR; PG8_SCHED;
            PG8_LDB(B1, 0, 1); PG8_STAGE(PG8_SB(0, 0), b2, voffB);
            PG8_BAR; PG8_WAIT_L(0); PG8_MMA(0, 1, At, B1); PG8_BAR;
            PG8_LDA(At, 0, 1); PG8_STAGE(PG8_SA(0, 0), a2, voffA);
            PG8_BAR; PG8_WAIT_L(0); PG8_MMA(1, 0, At, B0); PG8_BAR; PG8_SCHED;
            PG8_STAGE(PG8_SB(0, 1), b2 + hstep, voffB);
            PG8_WAIT_V(6); PG8_BAR; PG8_MMA(1, 1, At, B1); PG8_BAR;
            PG8_LDB(B0, 1, 0); PG8_SCHED; PG8_LDA(At, 1, 0); PG8_STAGE(PG8_SA(0, 1), a2 + hstep, voffA);
            PG8_WAIT_L(8); PG8_BAR; PG8_WAIT_L(0); PG8_MMA(0, 0, At, B0); PG8_BAR; PG8_SCHED;
            PG8_LDB(B1, 1, 1); PG8_STAGE(PG8_SB(1, 0), b3, voffB);
            PG8_BAR; PG8_WAIT_L(0); PG8_MMA(0, 1, At, B1); PG8_BAR;
            PG8_LDA(At, 1, 1); PG8_STAGE(PG8_SA(1, 0), a3, voffA);
            PG8_BAR; PG8_WAIT_L(0); PG8_MMA(1, 0, At, B0); PG8_BAR; PG8_SCHED;
            PG8_STAGE(PG8_SB(1, 1), b3 + hstep, voffB);
            PG8_WAIT_V(6); PG8_BAR; PG8_MMA(1, 1, At, B1); PG8_BAR;
            }
        }
        if constexpr (ALIGN_EPI) { if (wr == 0) PG8_BAR; }
        if constexpr (!Epi::AFTER_DRAIN) { E(acc, cur, wr, wc, fr, fq); S.done(cur); }
        if (!has_next) break;
#pragma unroll
        for (int a = 0; a < 2; ++a)
#pragma unroll
            for (int b = 0; b < 2; ++b)
#pragma unroll
                for (int m = 0; m < 4; ++m)
#pragma unroll
                    for (int n = 0; n < 2; ++n) acc[a][b][m][n] = (f32x4){0.f, 0.f, 0.f, 0.f};
        cur = nxt; cA = nA; cB = nB; ++ui;
        if constexpr (ALIGN_EPI) { if (wr == 1) PG8_BAR; }
    }
    PG8_WAIT_V(0);
    if constexpr (!ALIGN_EPI) { if (wr == 0) PG8_BAR; }
    PG8_BAR;
    if constexpr (Epi::AFTER_DRAIN) { E.fused(acc, cur, wr, wc, fr, fq, lds, wid, lane); S.done(cur); }
#undef PG8_SA
#undef PG8_SB
#undef PG8_STAGE
#undef PG8_LDA
#undef PG8_LDB
#undef PG8_MMA
#undef PG8_WAIT_V
#undef PG8_WAIT_L
#undef PG8_BAR
#undef PG8_SCHED
}
}
#ifndef PG8_SP2
#define PG8_SP2 true
#endif
#ifndef PG8_ALIGN
#define PG8_ALIGN true
#endif
constexpr int NWAVES = 8;
#ifndef MK_N_LAUNCHES
#define MK_N_LAUNCHES 1
#endif
constexpr int N_LAUNCHES = MK_N_LAUNCHES;
constexpr int NPHASES = 11;

constexpr int BATCH = 16, T = 2048, D = 1024, M = BATCH * T;
constexpr int DR = 512, HS = 64, NH = 8, DC = 512, CWID = 31, DIN = 2816, DRIN = 1792, FF = 4096;
constexpr int NLU = 1536, KLU = 256;
constexpr float RMS_EPS = 1e-6f, GN_EPS = 64e-5f, LN_EPS = 1e-5f;

constexpr size_t MiB = 1u << 20;
constexpr size_t WS_CTL = 0, CTL_ZERO_BYTES = 1 * MiB;
constexpr size_t WS_RINV1 = 1 * MiB;
constexpr size_t WS_BONUS = 2 * MiB;
constexpr size_t WS_SSQ2 = 3 * MiB;
constexpr size_t WS_WIN = 6 * MiB, WS_WOUT = 12 * MiB, WS_W1 = 14 * MiB, WS_W2 = 22 * MiB, WS_WCAT = 30 * MiB;
constexpr size_t WS_XB = 32 * MiB;
constexpr size_t WS_P = 96 * MiB;
constexpr size_t WS_K2 = 272 * MiB, WS_KK = 304 * MiB, WS_BV = 336 * MiB;
constexpr size_t WS_WD = 368 * MiB;
constexpr size_t WS_Y = 432 * MiB;
constexpr size_t WS_H = 96 * MiB;
constexpr size_t WS_END = 496 * MiB;
constexpr size_t DO_LU = 0, DO_LA = 96 * MiB;
static_assert(WS_H + (size_t)M * FF * 2 <= WS_Y && WS_Y + (size_t)M * DR * 4 <= WS_END && WS_P + (size_t)M * DIN * 2 <= WS_K2, "ws map");
constexpr int CW_BAR = 4096;

constexpr int RING_OFF = 0, RING_BYTES = 131072;
constexpr int LDSCTL_OFF = RING_BYTES, MISC_OFF = LDSCTL_OFF + 320;
constexpr int LDS_BYTES = 147456;

#define GAS __attribute__((address_space(1)))
#define LAS __attribute__((address_space(3)))
typedef unsigned short bf16;
typedef unsigned v4u __attribute__((ext_vector_type(4)));
typedef unsigned v2u __attribute__((ext_vector_type(2)));
typedef float f32x4 __attribute__((ext_vector_type(4)));
typedef GAS unsigned gu32;
#define RLX_AGENT __ATOMIC_RELAXED, __HIP_MEMORY_SCOPE_AGENT
#define LDS_WAIT() asm volatile("s_waitcnt lgkmcnt(0)" ::: "memory")
#define VM_WAIT() asm volatile("s_waitcnt vmcnt(0)" ::: "memory")
__device__ __forceinline__ unsigned f2bf(float f) { unsigned u = __builtin_bit_cast(unsigned, f); return (u + 0x7fffu + ((u >> 16) & 1u)) >> 16; }
__device__ __forceinline__ unsigned pk2(float lo, float hi) { return f2bf(lo) | (f2bf(hi) << 16); }
__device__ __forceinline__ float bflo(unsigned w) { return __builtin_bit_cast(float, w << 16); }
__device__ __forceinline__ float bfhi(unsigned w) { return __builtin_bit_cast(float, w & 0xffff0000u); }
__device__ __forceinline__ float bf1(bf16 h) { return __builtin_bit_cast(float, (unsigned)h << 16); }
__device__ __forceinline__ float sigmoidf_(float x) { return 1.0f / (1.0f + __expf(-x)); }
#define XB_TMO      128
#define XB_XCNT(j)  (256  + 64 * (j))
#define XB_XSUB(j)  (1280 + 64 * (j))
#define XB_XGEN(j)  (2304 + 64 * (j))
#define XB_TOP      3328
#define XB_TOPGEN   3392
#define XCD_BAR_WORDS 3456
#define XB_SPIN_CAP (1u << 18)

__device__ __forceinline__ unsigned xb_ld(unsigned* p)              { return __hip_atomic_load(p, __ATOMIC_RELAXED, __HIP_MEMORY_SCOPE_AGENT); }
__device__ __forceinline__ unsigned xb_add(unsigned* p, unsigned v) { return __hip_atomic_fetch_add(p, v, __ATOMIC_RELAXED, __HIP_MEMORY_SCOPE_AGENT); }
__device__ __forceinline__ unsigned xb_xcc_id() { return (unsigned)__builtin_amdgcn_s_getreg((3 << 11) | 20) & 0xFu; }
#define XB_SPIN(cond, bar) do { unsigned _sp = 0; while (cond) { __builtin_amdgcn_s_sleep(1); \
    if ((++_sp & 255u) == 0u) { if (xb_ld(&(bar)[XB_TMO])) break; if (_sp > XB_SPIN_CAP) { atomicAdd(&(bar)[XB_TMO], 1u); break; } } } } while (0)

struct XcdBarrier {
    unsigned* bar; unsigned x;
    volatile LAS unsigned* st;
};

__device__ __forceinline__ XcdBarrier xcd_barrier_post(unsigned* bar, volatile LAS unsigned* st) {
    XcdBarrier b; b.bar = bar; b.x = xb_xcc_id(); b.st = st;
    if (threadIdx.x == 0) (void)xb_add(&bar[XB_XCNT(b.x)], 1u);
    return b;
}
__device__ __forceinline__ void xcd_barrier_complete(unsigned* bar, unsigned x, unsigned& nloc, unsigned& nx) {
    const unsigned G = gridDim.x * gridDim.y * gridDim.z;
    unsigned sum, cnt, mine, sp = 0u;
    for (;;) {
        sum = 0u; cnt = 0u; mine = 0u;
#pragma unroll
        for (unsigned j = 0; j < 16; ++j) { const unsigned c = xb_ld(&bar[XB_XCNT(j)]); sum += c; cnt += (c > 0u) ? 1u : 0u; mine = (j == x) ? c : mine; }
        if (sum == G) break;
        __builtin_amdgcn_s_sleep(1);
        if ((++sp & 255u) == 0u) { if (xb_ld(&bar[XB_TMO])) break; if (sp > XB_SPIN_CAP) { atomicAdd(&bar[XB_TMO], 1u); break; } }
    }
    nloc = mine > 0u ? mine : 1u; nx = cnt > 0u ? cnt : 1u;
}

__device__ __forceinline__ void xcd_barrier(const XcdBarrier& b) {
    asm volatile("s_waitcnt vmcnt(0)" ::: "memory");
    __syncthreads();
    if (threadIdx.x == 0) {
        unsigned* bar = b.bar;
        __builtin_amdgcn_s_waitcnt(0);
        unsigned nloc = b.st[0], nx = b.st[1];
        if (nloc == 0u) { xcd_barrier_complete(bar, b.x, nloc, nx); b.st[0] = nloc; b.st[1] = nx; }
        const unsigned old = xb_add(&bar[XB_XSUB(b.x)], 1u);
        const unsigned gen = old / nloc;
        if (old + 1u == (gen + 1u) * nloc) {
            __builtin_amdgcn_fence(__ATOMIC_RELEASE, "agent");
            asm volatile("s_waitcnt vmcnt(0)" ::: "memory");
            const unsigned og = xb_add(&bar[XB_TOP], 1u);
            const unsigned tg = og / nx;
            if (og + 1u == (tg + 1u) * nx) xb_add(&bar[XB_TOPGEN], 1u);
            else XB_SPIN(xb_ld(&bar[XB_TOPGEN]) == tg, bar);
            __builtin_amdgcn_fence(__ATOMIC_ACQUIRE, "agent");
            xb_add(&bar[XB_XGEN(b.x)], 1u);
            asm volatile("s_waitcnt vmcnt(0)" ::: "memory");
        } else {
            XB_SPIN(xb_ld(&bar[XB_XGEN(b.x)]) == gen, bar);
            __builtin_amdgcn_fence(__ATOMIC_ACQUIRE, "agent");
            asm volatile("s_waitcnt vmcnt(0)" ::: "memory");
        }
    }
    __syncthreads();
}
template <int CTRL> __device__ __forceinline__ float dpp_f(float v) { return __builtin_bit_cast(float, __builtin_amdgcn_update_dpp(0, __builtin_bit_cast(int, v), CTRL, 0xF, 0xF, true)); }
__device__ __forceinline__ float sum16(float v) {
    v += dpp_f<0xB1>(v);
    v += dpp_f<0x4E>(v);
    v += dpp_f<0x141>(v);
    v += dpp_f<0x140>(v);
    return v;
}
__device__ __forceinline__ float sum8(float v) {
    v += dpp_f<0xB1>(v); v += dpp_f<0x4E>(v); v += dpp_f<0x141>(v);
    return v;
}
__device__ __forceinline__ float wave_sum(float v) {
    v = sum16(v);
    const int vi_ = __builtin_bit_cast(int, v);
    const float a = __builtin_bit_cast(float, __builtin_amdgcn_readlane(vi_, 0)), b = __builtin_bit_cast(float, __builtin_amdgcn_readlane(vi_, 16)), c = __builtin_bit_cast(float, __builtin_amdgcn_readlane(vi_, 32)), d = __builtin_bit_cast(float, __builtin_amdgcn_readlane(vi_, 48));
    return (a + b) + (c + d);
}
__device__ __forceinline__ void unpack8(const v4u w, float (&f)[8]) {
#pragma unroll
    for (int i = 0; i < 4; ++i) { f[2 * i] = bflo(w[i]); f[2 * i + 1] = bfhi(w[i]); }
}
__device__ __forceinline__ v4u pack8(const float (&f)[8]) { v4u o; o.x = pk2(f[0], f[1]); o.y = pk2(f[2], f[3]); o.z = pk2(f[4], f[5]); o.w = pk2(f[6], f[7]); return o; }
__device__ __forceinline__ void ld8(const float* p, float (&f)[8]) { const f32x4 a = *(const f32x4*)p, b = *(const f32x4*)(p + 4);
#pragma unroll
    for (int i = 0; i < 4; ++i) { f[i] = a[i]; f[4 + i] = b[i]; } }
__device__ __forceinline__ void p0_transpose_item(const float* W, int K, int N, const float* gain, bf16* WT, LAS float* scr, int item, int lane) {
    const int nblk = N / 32, kb = item / nblk, nb = item % nblk, k0 = 64 * kb, n0 = 32 * nb;
#pragma unroll 8
    for (int i = 0; i < 32; ++i) { const int kk = 2 * i + (lane >> 5); const float gv = gain ? gain[k0 + kk] : 1.0f; scr[kk * 33 + (lane & 31)] = W[(size_t)(k0 + kk) * N + n0 + (lane & 31)] * gv; }
    LDS_WAIT(); asm volatile("" ::: "memory");
    const int c = lane & 7;
#pragma unroll
    for (int j = 0; j < 4; ++j) { const int n = (lane >> 3) + 8 * j; const LAS float* s = scr + (8 * c) * 33 + n;
        v4u o; o.x = pk2(s[0 * 33], s[1 * 33]); o.y = pk2(s[2 * 33], s[3 * 33]); o.z = pk2(s[4 * 33], s[5 * 33]); o.w = pk2(s[6 * 33], s[7 * 33]);
        *(GAS v4u*)(WT + (size_t)(n0 + n) * K + k0 + 8 * c) = o; }
    LDS_WAIT(); asm volatile("" ::: "memory");
}
struct In {
    const float *x, *g_mix, *w_in, *mu, *w0, *wdu, *a0, *wau, *wgu, *k_k, *k_a, *r_k, *lnx_g, *lnx_b, *conv_w, *conv_b, *cln_g, *cln_b, *w_out, *g_mlp, *w_ff1, *w_ff2, *g_fin;
};

__device__ __forceinline__ void p0_prologue(LAS unsigned char* lds, const In& I, unsigned char* ws, int gw, int NGW, int wave, int lane) {
    LAS float* scr = (LAS float*)(lds + RING_OFF + wave * 16384);
    bf16* Win_t = (bf16*)(ws + WS_WIN); bf16* Wout_t = (bf16*)(ws + WS_WOUT); bf16* W1_t = (bf16*)(ws + WS_W1); bf16* W2_t = (bf16*)(ws + WS_W2); bf16* Wcat_t = (bf16*)(ws + WS_WCAT);
    constexpr int I_IN = (D / 64) * (DIN / 32), I_O = (D / 64) * (D / 32), I_1 = (D / 64) * (FF / 32), I_2 = (FF / 64) * (D / 32);
    constexpr int NITEMS = I_IN + I_O + I_1 + I_2;
    for (int it = gw; it < NITEMS; it += NGW) {
        int r = it;
        if (r < I_IN) { p0_transpose_item(I.w_in, D, DIN, I.g_mix, Win_t, scr, r, lane); continue; } r -= I_IN;
        if (r < I_O) { p0_transpose_item(I.w_out, D, D, nullptr, Wout_t, scr, r, lane); continue; } r -= I_O;
        if (r < I_1) { p0_transpose_item(I.w_ff1, D, FF, I.g_mlp, W1_t, scr, r, lane); continue; } r -= I_1;
        p0_transpose_item(I.w_ff2, FF, D, nullptr, W2_t, scr, r, lane);
    }
    for (int idx = gw * 64 + lane; idx < NLU * KLU / 8; idx += NGW * 64) {
        const int n = idx / (KLU / 8), k8 = (idx % (KLU / 8)) * 8, blk = n / 512, nn = n % 512; float v[8];
#pragma unroll
        for (int j = 0; j < 8; ++j) { const int k = k8 + j; float x = 0.f;
            if (blk == 0 && k < 64) x = I.wdu[(size_t)k * 512 + nn];
            if (blk == 1 && k >= 64 && k < 128) x = I.wau[(size_t)(k - 64) * 512 + nn];
            if (blk == 2 && k >= 128) x = I.wgu[(size_t)(k - 128) * 512 + nn];
            v[j] = x; }
        v4u o; o.x = pk2(v[0], v[1]); o.y = pk2(v[2], v[3]); o.z = pk2(v[4], v[5]); o.w = pk2(v[6], v[7]);
        *(GAS v4u*)(Wcat_t + (size_t)n * KLU + k8) = o;
    }
    bf16* XB = (bf16*)(ws + WS_XB); float* rinv1 = (float*)(ws + WS_RINV1);
    for (int m = gw; m < M; m += NGW) {
        const GAS f32x4* xr = (const GAS f32x4*)(I.x + (size_t)m * D) + lane;
        f32x4 v[4]; float s = 0.f;
#pragma unroll
        for (int j = 0; j < 4; ++j) { v[j] = xr[64 * j]; s += (v[j].x * v[j].x + v[j].y * v[j].y) + (v[j].z * v[j].z + v[j].w * v[j].w); }
        const float tot = wave_sum(s);
        GAS unsigned long long* o8 = (GAS unsigned long long*)(XB + (size_t)m * D) + lane;
#pragma unroll
        for (int j = 0; j < 4; ++j) o8[64 * j] = (unsigned long long)pk2(v[j].x, v[j].y) | ((unsigned long long)pk2(v[j].z, v[j].w) << 32);
        if (lane == 0) rinv1[m] = 1.0f / sqrtf(tot * (1.0f / D) + RMS_EPS);
    }
}

__device__ __forceinline__ void p2_lora_act(const bf16* P, const float* mu, bf16* LA, int gtid, int NT) {
    for (int item = gtid; item < M * (KLU / 8); item += NT) {
        const int m = item / (KLU / 8), j8 = (item % (KLU / 8)) * 8, col = 3 * DR + j8;
        const v4u c = *(const GAS v4u*)(P + (size_t)m * DIN + col);
        v4u p = (v4u){0u, 0u, 0u, 0u};
        if ((m % T) != 0) p = *(const GAS v4u*)(P + (size_t)(m - 1) * DIN + col);
        float v[8];
#pragma unroll
        for (int w = 0; w < 4; ++w) { const unsigned cw = c[w], pw = p[w];
            const float c0 = bflo(cw), c1 = bfhi(cw), p0 = bflo(pw), p1 = bfhi(pw);
            v[2 * w] = c0 + (p0 - c0) * mu[col + 2 * w]; v[2 * w + 1] = c1 + (p1 - c1) * mu[col + 2 * w + 1]; }
#pragma unroll
        for (int j = 0; j < 8; ++j) { if (j8 < 64) v[j] = tanhf(v[j]); else if (j8 >= 128) v[j] = sigmoidf_(v[j]); }
        v4u o; o.x = pk2(v[0], v[1]); o.y = pk2(v[2], v[3]); o.z = pk2(v[4], v[5]); o.w = pk2(v[6], v[7]);
        *(GAS v4u*)(LA + (size_t)m * KLU + j8) = o;
    }
}

constexpr int CTT = 64, CHALO = CWID - 1, CROWS = CTT + CHALO, CHS_BYTES = CROWS * DC * 2;
__device__ __forceinline__ void p2_conv(LAS unsigned char* lds, const bf16* P, const In& I, bf16* YCAT, int vcu, int G, int tid, int wave, int lane) {
    LAS unsigned char* Hs = lds + RING_OFF;
    LAS float* Cs = (LAS float*)(lds + RING_OFF + CHS_BYTES);
    static_assert(CHS_BYTES % 16 == 0 && CHS_BYTES + 16 * DC * 4 <= RING_BYTES, "conv LDS");
    const int cp = tid & 255, th = tid >> 8;
    float cw0[CWID], cw1[CWID];
#pragma unroll
    for (int j = 0; j < CWID; ++j) { cw0[j] = I.conv_w[j * DC + 2 * cp]; cw1[j] = I.conv_w[j * DC + 2 * cp + 1]; }
    const float cb0 = I.conv_b[2 * cp], cb1 = I.conv_b[2 * cp + 1];
    float lg[8], lb[8]; ld8(I.cln_g + lane * 8, lg); ld8(I.cln_b + lane * 8, lb);
    for (int tile = vcu; tile < M / CTT; tile += G) {
        const int m0 = tile * CTT, t0 = m0 % T;
#pragma unroll 1
        for (int g = 0; g < 3; ++g) {
            v4u av[4], bv[4];
#pragma unroll
            for (int q = 0; q < 4; ++q) { const int item = (g * 4 + q) * 512 + tid, row = item >> 6, ch8 = (item & 63) * 8; const bool valid = (row < CROWS) && (t0 - CHALO + row >= 0);
                av[q] = (v4u){0u, 0u, 0u, 0u}; bv[q] = (v4u){0u, 0u, 0u, 0u};
                if (valid) { const size_t rb = (size_t)(m0 - CHALO + row) * DIN + DRIN + ch8; av[q] = *(const GAS v4u*)(P + rb); bv[q] = *(const GAS v4u*)(P + rb + DC); } }
#pragma unroll
            for (int q = 0; q < 4; ++q) { const int item = (g * 4 + q) * 512 + tid, row = item >> 6, ch8 = (item & 63) * 8;
                float a[8], b[8], h[8]; unpack8(av[q], a); unpack8(bv[q], b);
#pragma unroll
                for (int e = 0; e < 8; ++e) h[e] = a[e] * sigmoidf_(b[e]);
                if (row < CROWS) *(LAS v4u*)(Hs + row * (DC * 2) + ch8 * 2) = pack8(h); }
        }
        __syncthreads();
#pragma unroll 1
        for (int blk = 0; blk < 4; ++blk) {
            const int tok0 = th * 32 + blk * 8;
            float acc0[8], acc1[8];
#pragma unroll
            for (int o = 0; o < 8; ++o) { acc0[o] = cb0; acc1[o] = cb1; }
#pragma unroll
            for (int i = 0; i < 38; ++i) { const unsigned x = *(const LAS unsigned*)(Hs + (tok0 + i) * (DC * 2) + cp * 4); const float x0 = bflo(x), x1 = bfhi(x);
#pragma unroll
                for (int o = 0; o < 8; ++o) { const int j = i - o; if (j >= 0 && j < CWID) { acc0[o] += cw0[j] * x0; acc1[o] += cw1[j] * x1; } } }
#pragma unroll
            for (int o = 0; o < 8; ++o) { typedef float f32x2 __attribute__((ext_vector_type(2))); *(LAS f32x2*)(Cs + (th * 8 + o) * DC + 2 * cp) = (f32x2){acc0[o], acc1[o]}; }
            __syncthreads();
#pragma unroll
            for (int q = 0; q < 2; ++q) { const int row = wave * 2 + q, tt = (row >> 3) * 32 + blk * 8 + (row & 7); const LAS f32x4* cp4 = (const LAS f32x4*)(Cs + row * DC + lane * 8);
                const f32x4 a = cp4[0], b = cp4[1];
                const float mean = wave_sum((a.x + a.y) + (a.z + a.w) + (b.x + b.y) + (b.z + b.w)) * (1.0f / DC);
                const f32x4 da = a - mean, db = b - mean;
                const float var = wave_sum((da.x * da.x + da.y * da.y) + (da.z * da.z + da.w * da.w) + (db.x * db.x + db.y * db.y) + (db.z * db.z + db.w * db.w)) * (1.0f / DC);
                const float rstd = 1.0f / sqrtf(var + LN_EPS);
                float o[8];
#pragma unroll
                for (int e = 0; e < 4; ++e) { const float h0 = da[e] * rstd * lg[e] + lb[e], h1 = db[e] * rstd * lg[4 + e] + lb[4 + e]; o[e] = h0 * sigmoidf_(h0); o[4 + e] = h1 * sigmoidf_(h1); }
                *(GAS v4u*)(YCAT + (size_t)(m0 + tt) * D + DR + lane * 8) = pack8(o); }
            __syncthreads();
        }
    }
}

__device__ __forceinline__ void p4_prep(const bf16* P, const bf16* LU, const In& I, unsigned char* ws, int gw, int NGW, int lane) {
    bf16* K2 = (bf16*)(ws + WS_K2); bf16* KK = (bf16*)(ws + WS_KK); bf16* BV = (bf16*)(ws + WS_BV); float* WD = (float*)(ws + WS_WD); float* BONUS = (float*)(ws + WS_BONUS);
    const int col = lane * 8;
    float mu_r[8], mu_k[8], w0[8], a0[8], kkc[8], kac[8], rkc[8];
    ld8(I.mu + col, mu_r); ld8(I.mu + DR + col, mu_k); ld8(I.w0 + col, w0); ld8(I.a0 + col, a0); ld8(I.k_k + col, kkc); ld8(I.k_a + col, kac); ld8(I.r_k + col, rkc);
    constexpr int TPW = 16, U = 4;
    for (int m0 = gw * TPW; m0 < M; m0 += NGW * TPW) {
        v4u pr = (v4u){0u, 0u, 0u, 0u}, pk = (v4u){0u, 0u, 0u, 0u};
        if ((m0 % T) != 0) { pr = *(const GAS v4u*)(P + (size_t)(m0 - 1) * DIN + col); pk = *(const GAS v4u*)(P + (size_t)(m0 - 1) * DIN + DR + col); }
#pragma unroll 1
        for (int i0 = 0; i0 < TPW; i0 += U) {
            v4u cr[U], ck[U], cdw[U], cda[U];
#pragma unroll
            for (int u = 0; u < U; ++u) { const size_t m = (size_t)(m0 + i0 + u);
                cr[u] = *(const GAS v4u*)(P + m * DIN + col); ck[u] = *(const GAS v4u*)(P + m * DIN + DR + col);
                cdw[u] = *(const GAS v4u*)(LU + m * NLU + col); cda[u] = *(const GAS v4u*)(LU + m * NLU + 512 + col); }
#pragma unroll
            for (int u = 0; u < U; ++u) { const size_t m = (size_t)(m0 + i0 + u);
                float rc[8], rp[8], kc[8], kp[8], dw[8], da[8];
                unpack8(cr[u], rc); unpack8(pr, rp); unpack8(ck[u], kc); unpack8(pk, kp); unpack8(cdw[u], dw); unpack8(cda[u], da);
                pr = cr[u]; pk = ck[u];
                float k2[8], kr[8], as[8], dec[8]; float n2 = 0.f, bon = 0.f;
#pragma unroll
                for (int e = 0; e < 8; ++e) {
                    const float r = rc[e] + (rp[e] - rc[e]) * mu_r[e], k = kc[e] + (kp[e] - kc[e]) * mu_k[e];
                    const float z = -(w0[e] + dw[e]);
                    const float sp = fmaxf(z, 0.f) + __logf(1.0f + __expf(-fabsf(z)));
                    dec[e] = __expf(-__expf(-sp - 0.5f));
                    as[e] = 1.0f / (1.0f + __expf(-(a0[e] + da[e])));
                    kr[e] = k * kkc[e]; n2 += kr[e] * kr[e];
                    k2[e] = k * (1.0f + (as[e] - 1.0f) * kac[e]);
                    bon += r * k2[e] * rkc[e]; }
                n2 = sum8(n2); bon = sum8(bon);
                const float inv = 1.0f / fmaxf(sqrtf(n2), 1e-12f);
                float kn[8], bv[8];
#pragma unroll
                for (int e = 0; e < 8; ++e) { kn[e] = kr[e] * inv; bv[e] = kn[e] * as[e]; }
                const size_t o = m * DR + col;
                *(GAS v4u*)(K2 + o) = pack8(k2); *(GAS v4u*)(KK + o) = pack8(kn); *(GAS v4u*)(BV + o) = pack8(bv);
                *(GAS f32x4*)(WD + o) = (f32x4){dec[0], dec[1], dec[2], dec[3]}; *(GAS f32x4*)(WD + o + 4) = (f32x4){dec[4], dec[5], dec[6], dec[7]};
                if ((lane & 7) == 0) BONUS[m * NH + (lane >> 3)] = bon; }
        }
    }
}

constexpr int TC = 32, NCH = T / TC, SBUF = 5 * TC * 64 * 4 + TC * 32 * 4;
__device__ __forceinline__ void p5_scan(LAS unsigned char* lds, const bf16* P, const float* mu, const unsigned char* ws, float* Y, int unit, int tid) {
    static_assert(2 * SBUF <= RING_BYTES, "scan LDS");
    const bf16* K2 = (const bf16*)(ws + WS_K2); const bf16* KK = (const bf16*)(ws + WS_KK); const bf16* BV = (const bf16*)(ws + WS_BV); const float* WD = (const float*)(ws + WS_WD);
    const int bh = unit >> 1, half = unit & 1, b = bh >> 3, h = bh & 7;
    const int rowl = tid >> 4, seg = tid & 15;
    const int si = tid >> 4, se = (tid & 15) * 4;
    const int vi = (tid & 255) >> 3, vj = (tid & 7) * 4;
    const f32x4 mur = *(const f32x4*)(mu + h * 64 + se);
    const f32x4 muv = *(const f32x4*)(mu + 2 * DR + h * 64 + half * 32 + vj);
    const size_t mrow0 = (size_t)b * T;
    v2u gk2, gkk, gbv, gr, grp, gv, gvp; f32x4 gw;
    auto issue = [&](int c) {
        const int t = c * TC + si; const size_t m = mrow0 + t; const size_t o = m * DR + h * 64 + se;
        gk2 = *(const GAS v2u*)(K2 + o); gkk = *(const GAS v2u*)(KK + o); gbv = *(const GAS v2u*)(BV + o); gw = *(const GAS f32x4*)(WD + o);
        gr = *(const GAS v2u*)(P + m * DIN + h * 64 + se);
        grp = (v2u){0u, 0u}; if (t > 0) grp = *(const GAS v2u*)(P + (m - 1) * DIN + h * 64 + se);
        if (tid < 256) { const int tv = c * TC + vi; const size_t mv = mrow0 + tv; const size_t ov = mv * DIN + 2 * DR + h * 64 + half * 32 + vj;
            gv = *(const GAS v2u*)(P + ov); gvp = (v2u){0u, 0u}; if (tv > 0) gvp = *(const GAS v2u*)(P + ov - DIN); }
    };
    auto commit = [&](int p) {
        LAS unsigned char* bp = lds + RING_OFF + p * SBUF;
        LAS f32x4* R4 = (LAS f32x4*)(bp); LAS f32x4* W4 = (LAS f32x4*)(bp + 8192); LAS f32x4* K4 = (LAS f32x4*)(bp + 16384); LAS f32x4* Q4 = (LAS f32x4*)(bp + 24576); LAS f32x4* B4 = (LAS f32x4*)(bp + 32768);
        LAS f32x4* V4 = (LAS f32x4*)(bp + 40960);
        const int idx = si * 16 + (tid & 15);
        f32x4 rc = (f32x4){bflo(gr.x), bfhi(gr.x), bflo(gr.y), bfhi(gr.y)}, rp = (f32x4){bflo(grp.x), bfhi(grp.x), bflo(grp.y), bfhi(grp.y)};
        R4[idx] = rc + (rp - rc) * mur;
        W4[idx] = gw;
        K4[idx] = (f32x4){bflo(gk2.x), bfhi(gk2.x), bflo(gk2.y), bfhi(gk2.y)};
        Q4[idx] = (f32x4){bflo(gkk.x), bfhi(gkk.x), bflo(gkk.y), bfhi(gkk.y)};
        B4[idx] = (f32x4){bflo(gbv.x), bfhi(gbv.x), bflo(gbv.y), bfhi(gbv.y)};
        if (tid < 256) { f32x4 vc = (f32x4){bflo(gv.x), bfhi(gv.x), bflo(gv.y), bfhi(gv.y)}, vp = (f32x4){bflo(gvp.x), bfhi(gvp.x), bflo(gvp.y), bfhi(gvp.y)};
            V4[vi * 8 + (tid & 7)] = vc + (vp - vc) * muv; }
    };
    typedef float f32x2 __attribute__((ext_vector_type(2)));
    f32x2 sA = (f32x2){0.f, 0.f}, sB = (f32x2){0.f, 0.f};
    issue(0); commit(0); __syncthreads();
    float* ybase = Y + mrow0 * DR + h * 64 + half * 32;
    LAS float* YB = (LAS float*)(lds + RING_OFF + 2 * SBUF);
    static_assert(2 * SBUF + 2 * TC * 32 * 4 <= RING_BYTES, "scan LDS");
    for (int c = 0; c < NCH; ++c) {
        if (c > 0 && tid < 256) {
            const f32x4 yv = *(const LAS f32x4*)(YB + ((c - 1) & 1) * (TC * 32) + vi * 32 + vj);
            *(GAS f32x4*)(ybase + (size_t)((c - 1) * TC + vi) * DR + vj) = yv; }
        if (c + 1 < NCH) issue(c + 1);
        const LAS unsigned char* bp = lds + RING_OFF + (c & 1) * SBUF;
        const LAS f32x4* R4 = (const LAS f32x4*)(bp); const LAS f32x4* W4 = (const LAS f32x4*)(bp + 8192); const LAS f32x4* K4 = (const LAS f32x4*)(bp + 16384); const LAS f32x4* Q4 = (const LAS f32x4*)(bp + 24576); const LAS f32x4* B4 = (const LAS f32x4*)(bp + 32768);
        const LAS float* V1 = (const LAS float*)(bp + 40960);
        LAS float* Yc = YB + (c & 1) * (TC * 32) + rowl;
        f32x4 nq = Q4[seg], nw = W4[seg], nb = B4[seg], nk = K4[seg], nr = R4[seg]; float nv = V1[rowl];
#pragma unroll 8
        for (int i = 0; i < TC; ++i) {
            const f32x4 q = nq, w = nw, bb = nb, kk = nk, r = nr; const float v = nv;
            { const int j = (i + 1 < TC) ? i + 1 : i;
              nq = Q4[j * 16 + seg]; nw = W4[j * 16 + seg]; nb = B4[j * 16 + seg]; nk = K4[j * 16 + seg]; nr = R4[j * 16 + seg]; nv = V1[j * 32 + rowl]; }
            const f32x2 t = sA * q.xy + sB * q.zw;
            const float sk = sum16(t.x + t.y);
            sA = sA * w.xy + kk.xy * v; sB = sB * w.zw + kk.zw * v;
            sA = sA - bb.xy * sk; sB = sB - bb.zw * sk;
            const f32x2 u = sA * r.xy + sB * r.zw;
            Yc[i * 32] = sum16(u.x + u.y);
        }
        if (c + 1 < NCH) commit((c + 1) & 1);
        __syncthreads();
    }
    if (tid < 256) { const f32x4 yv = *(const LAS f32x4*)(YB + ((NCH - 1) & 1) * (TC * 32) + vi * 32 + vj);
        *(GAS f32x4*)(ybase + (size_t)((NCH - 1) * TC + vi) * DR + vj) = yv; }
    __syncthreads();
}

__device__ __forceinline__ void p6_post(const bf16* P, const bf16* LU, const In& I, const unsigned char* ws, bf16* YCAT, int gw, int NGW, int lane) {
    const float* Y = (const float*)(ws + WS_Y); const float* BONUS = (const float*)(ws + WS_BONUS);
    const int col = lane * 8;
    float mu_v[8], lg[8], lb[8];
    ld8(I.mu + 2 * DR + col, mu_v); ld8(I.lnx_g + col, lg); ld8(I.lnx_b + col, lb);
    constexpr int TPW = 16, U = 4;
    for (int m0 = gw * TPW; m0 < M; m0 += NGW * TPW) {
        v4u pv = (v4u){0u, 0u, 0u, 0u};
        if ((m0 % T) != 0) pv = *(const GAS v4u*)(P + (size_t)(m0 - 1) * DIN + 2 * DR + col);
#pragma unroll 1
        for (int i0 = 0; i0 < TPW; i0 += U) {
            v4u cv[U], cg[U]; f32x4 y0[U], y1[U]; float bo[U];
#pragma unroll
            for (int u = 0; u < U; ++u) { const size_t m = (size_t)(m0 + i0 + u);
                cv[u] = *(const GAS v4u*)(P + m * DIN + 2 * DR + col); cg[u] = *(const GAS v4u*)(LU + m * NLU + 1024 + col);
                y0[u] = *(const GAS f32x4*)(Y + m * DR + col); y1[u] = *(const GAS f32x4*)(Y + m * DR + col + 4); bo[u] = BONUS[m * NH + (lane >> 3)]; }
#pragma unroll
            for (int u = 0; u < U; ++u) { const size_t m = (size_t)(m0 + i0 + u);
                float vc[8], vp[8], g[8], y[8];
                unpack8(cv[u], vc); unpack8(pv, vp); unpack8(cg[u], g); pv = cv[u];
#pragma unroll
                for (int e = 0; e < 4; ++e) { y[e] = y0[u][e]; y[4 + e] = y1[u][e]; }
                float sm = 0.f;
#pragma unroll
                for (int e = 0; e < 8; ++e) sm += y[e];
                const float mean = sum8(sm) * (1.0f / HS); float sq = 0.f;
#pragma unroll
                for (int e = 0; e < 8; ++e) { y[e] -= mean; sq += y[e] * y[e]; }
                const float rstd = 1.0f / sqrtf(sum8(sq) * (1.0f / HS) + GN_EPS);
                float o[8];
#pragma unroll
                for (int e = 0; e < 8; ++e) { const float v = vc[e] + (vp[e] - vc[e]) * mu_v[e]; o[e] = (y[e] * rstd * lg[e] + lb[e] + bo[u] * v) * g[e]; }
                *(GAS v4u*)(YCAT + m * D + col) = pack8(o); }
        }
    }
}

__device__ __forceinline__ void p10_final(float* out, const float* gfin, int gw, int NGW, int lane) {
    f32x4 gv[4];
#pragma unroll
    for (int j = 0; j < 4; ++j) gv[j] = *(const f32x4*)(gfin + 4 * lane + 256 * j);
    for (int m = gw; m < M; m += NGW) {
        GAS f32x4* xr = (GAS f32x4*)(out + (size_t)m * D) + lane;
        f32x4 v[4]; float s = 0.f;
#pragma unroll
        for (int j = 0; j < 4; ++j) { v[j] = xr[64 * j]; s += (v[j].x * v[j].x + v[j].y * v[j].y) + (v[j].z * v[j].z + v[j].w * v[j].w); }
        const float rinv = 1.0f / sqrtf(wave_sum(s) * (1.0f / D) + RMS_EPS);
#pragma unroll
        for (int j = 0; j < 4; ++j) xr[64 * j] = v[j] * rinv * gv[j];
    }
}
#ifndef REP_PHASE
#define REP_PHASE -1
#endif
#ifndef REP_COUNT
#define REP_COUNT 2
#endif
struct Args { const float* in[23]; float* out; unsigned char* ws; int ph_lo, ph_hi, li, pad; };
template <int LO, int HI> __global__ void __launch_bounds__(NWAVES * 64, 2) hymba_fwd(Args args) {
    extern __shared__ __attribute__((aligned(16))) unsigned char lds_raw[];
    LAS unsigned char* lds = (LAS unsigned char*)lds_raw;
    volatile LAS unsigned* MISC = (volatile LAS unsigned*)(lds + MISC_OFF);
    const int G = gridDim.x; const int bx = blockIdx.x; const int vcu = (G % 8 == 0) ? (bx % 8) * (G / 8) + bx / 8 : bx;
    const int NGW = G * NWAVES, NT = G * NWAVES * 64;
#define PHASE_IDS() int tid = threadIdx.x; asm volatile("" : "+v"(tid)); const int lane = tid & 63, wave = __builtin_amdgcn_readfirstlane(tid >> 6); const int gw = vcu * NWAVES + wave, gtid = vcu * (NWAVES * 64) + tid; (void)lane; (void)gw; (void)gtid
    typedef __attribute__((address_space(4))) const Args CArgs;
#define PHASE_ARGS() PHASE_IDS(); CArgs* ap = (CArgs*)__builtin_amdgcn_kernarg_segment_ptr(); asm volatile("" : "+s"(ap)); unsigned char* ws = ap->ws; float* out = ap->out; (void)ws; (void)out
#define LOAD_IN() In I; I.x = ap->in[0]; I.g_mix = ap->in[1]; I.w_in = ap->in[2]; I.mu = ap->in[3]; I.w0 = ap->in[4]; I.wdu = ap->in[5]; I.a0 = ap->in[6]; I.wau = ap->in[7]; I.wgu = ap->in[8]; \
    I.k_k = ap->in[9]; I.k_a = ap->in[10]; I.r_k = ap->in[11]; I.lnx_g = ap->in[12]; I.lnx_b = ap->in[13]; I.conv_w = ap->in[14]; I.conv_b = ap->in[15]; I.cln_g = ap->in[16]; I.cln_b = ap->in[17]; \
    I.w_out = ap->in[18]; I.g_mlp = ap->in[19]; I.w_ff1 = ap->in[20]; I.w_ff2 = ap->in[21]; I.g_fin = ap->in[22]
    gu32* ctl = (gu32*)(args.ws + WS_CTL);
    for (int u = threadIdx.x; u < (LDS_BYTES - LDSCTL_OFF) / 4; u += NWAVES * 64) ((LAS unsigned*)(lds + LDSCTL_OFF))[u] = 0u;
    __syncthreads();
    XcdBarrier bar; bar.bar = (unsigned*)(ctl + CW_BAR); bar.x = 0; bar.st = nullptr;
    if (HI - LO > 1) bar = xcd_barrier_post((unsigned*)(ctl + CW_BAR), MISC + 8);
#define GRID_BAR() do { if (HI - LO > 1) xcd_barrier(bar); } while (0)
#define IN(k) (LO <= (k) && (k) < HI)
#define BOTH(k) (IN(k) && IN((k) + 1))

    for (int rep_ = 0; rep_ < ((REP_PHASE == 0) ? REP_COUNT : 1); ++rep_) if (IN(0)) { PHASE_ARGS(); LOAD_IN(); p0_prologue(lds, I, ws, gw, NGW, wave, lane); if (BOTH(0)) GRID_BAR(); }
    for (int rep_ = 0; rep_ < ((REP_PHASE == 1) ? REP_COUNT : 1); ++rep_) if (IN(1)) { PHASE_ARGS();
        pg8::Gemm g{(bf16*)(ws + WS_XB), (bf16*)(ws + WS_WIN), M, DIN, D}; pg8::StaticOrder S; S.init(M, DIN, G, bx);
        pg8::EpiBf16RS<0, 1> E{(bf16*)(ws + WS_P), DIN, (const float*)(ws + WS_RINV1), 0.f};
        pg8::gemm_phase<pg8::EpiBf16RS<0, 1>, pg8::StaticOrder, PG8_ALIGN, PG8_SP2>(lds + RING_OFF, g, S, E);
        if (BOTH(1)) GRID_BAR();
    }
    for (int rep_ = 0; rep_ < ((REP_PHASE == 2) ? REP_COUNT : 1); ++rep_) if (IN(2)) { PHASE_ARGS(); LOAD_IN(); p2_lora_act((const bf16*)(ws + WS_P), I.mu, (bf16*)((unsigned char*)out + DO_LA), gtid, NT); p2_conv(lds, (const bf16*)(ws + WS_P), I, (bf16*)(ws + WS_XB), vcu, G, tid, wave, lane); if (BOTH(2)) GRID_BAR(); }
    for (int rep_ = 0; rep_ < ((REP_PHASE == 3) ? REP_COUNT : 1); ++rep_) if (IN(3)) { PHASE_ARGS();
        int kq = KLU; asm volatile("" : "+s"(kq));
        pg8::Gemm g{(bf16*)((unsigned char*)out + DO_LA), (bf16*)(ws + WS_WCAT), M, NLU, kq}; pg8::StaticOrder S; S.init(M, NLU, G, bx);
        pg8::EpiBf16RS<0, 0> E{(bf16*)((unsigned char*)out + DO_LU), NLU, nullptr, 0.f};
        pg8::gemm_phase<pg8::EpiBf16RS<0, 0>, pg8::StaticOrder, PG8_ALIGN, PG8_SP2>(lds + RING_OFF, g, S, E);
        if (BOTH(3)) GRID_BAR();
    }
    for (int rep_ = 0; rep_ < ((REP_PHASE == 4) ? REP_COUNT : 1); ++rep_) if (IN(4)) { PHASE_ARGS(); LOAD_IN(); p4_prep((const bf16*)(ws + WS_P), (const bf16*)((unsigned char*)out + DO_LU), I, ws, gw, NGW, lane); if (BOTH(4)) GRID_BAR(); }
    for (int rep_ = 0; rep_ < ((REP_PHASE == 5) ? REP_COUNT : 1); ++rep_) if (IN(5)) { PHASE_ARGS(); for (int unit = vcu; unit < BATCH * NH * 2; unit += G) p5_scan(lds, (const bf16*)(ws + WS_P), ap->in[3], ws, (float*)(ws + WS_Y), unit, tid); if (BOTH(5)) GRID_BAR(); }
    for (int rep_ = 0; rep_ < ((REP_PHASE == 6) ? REP_COUNT : 1); ++rep_) if (IN(6)) { PHASE_ARGS(); LOAD_IN(); p6_post((const bf16*)(ws + WS_P), (const bf16*)((unsigned char*)out + DO_LU), I, ws, (bf16*)(ws + WS_XB), gw, NGW, lane); if (BOTH(6)) GRID_BAR(); }
    for (int rep_ = 0; rep_ < ((REP_PHASE == 7) ? REP_COUNT : 1); ++rep_) if (IN(7)) { PHASE_ARGS();
        pg8::Gemm g{(bf16*)(ws + WS_XB), (bf16*)(ws + WS_WOUT), M, D, D}; pg8::StaticOrder S; S.init(M, D, G, bx);
        pg8::EpiResid<true> E{ap->in[0], out, (bf16*)(ws + WS_Y), (float*)(ws + WS_SSQ2), D};
        pg8::gemm_phase<pg8::EpiResid<true>, pg8::StaticOrder, PG8_ALIGN, PG8_SP2>(lds + RING_OFF, g, S, E);
        if (BOTH(7)) GRID_BAR();
    }
    for (int rep_ = 0; rep_ < ((REP_PHASE == 8) ? REP_COUNT : 1); ++rep_) if (IN(8)) { PHASE_ARGS();
        pg8::Gemm g{(bf16*)(ws + WS_Y), (bf16*)(ws + WS_W1), M, FF, D}; pg8::StaticOrder S; S.init(M, FF, G, bx);
        pg8::EpiBf16RS<2, 2> E{(bf16*)(ws + WS_H), FF, (const float*)(ws + WS_SSQ2), RMS_EPS};
        pg8::gemm_phase<pg8::EpiBf16RS<2, 2>, pg8::StaticOrder, PG8_ALIGN, PG8_SP2>(lds + RING_OFF, g, S, E);
        if (BOTH(8)) GRID_BAR();
    }
    for (int rep_ = 0; rep_ < ((REP_PHASE == 9) ? REP_COUNT : 1); ++rep_) if (IN(9)) { PHASE_ARGS();
        pg8::Gemm g{(bf16*)(ws + WS_H), (bf16*)(ws + WS_W2), M, D, FF}; pg8::StaticOrder S; S.init(M, D, G, bx);
        pg8::EpiResid<false> E{out, out, nullptr, nullptr, D};
        pg8::gemm_phase<pg8::EpiResid<false>, pg8::StaticOrder, PG8_ALIGN, PG8_SP2>(lds + RING_OFF, g, S, E);
        if (BOTH(9)) GRID_BAR();
    }
    for (int rep_ = 0; rep_ < ((REP_PHASE == 10) ? REP_COUNT : 1); ++rep_) if (IN(10)) { PHASE_ARGS(); p10_final(out, ap->in[22], gw, NGW, lane); }
#undef IN
#undef BOTH
}

#if MK_N_LAUNCHES == 1
static hipError_t set_attr_all(hipFuncAttribute at, int v) { return hipFuncSetAttribute((const void*)hymba_fwd<0, NPHASES>, at, v); }
template <int K> static void launch_phases(int, hipStream_t, Args&) {}
#define OCC_KERNEL hymba_fwd<0, NPHASES>
#else
template <int K> static hipError_t set_attr_k(hipFuncAttribute at, int v) { hipError_t e = hipFuncSetAttribute((const void*)hymba_fwd<K, K + 1>, at, v); if (e != hipSuccess) return e; if constexpr (K + 1 < NPHASES) return set_attr_k<K + 1>(at, v); else return hipSuccess; }
static hipError_t set_attr_all(hipFuncAttribute at, int v) { return set_attr_k<0>(at, v); }
#define OCC_KERNEL hymba_fwd<1, 2>
template <int K> static void launch_phases(int grid, hipStream_t stream, Args& a) {
    a.ph_lo = K; a.ph_hi = K + 1; a.li = K;
    hipLaunchKernelGGL((hymba_fwd<K, K + 1>), dim3(grid), dim3(NWAVES * 64), LDS_BYTES, stream, a);
    if constexpr (K + 1 < NPHASES) launch_phases<K + 1>(grid, stream, a);
}
#endif
extern "C" void kernel_launch(void* const* d_in, const int* in_sizes, int n_in, void* d_out, int out_size, void* d_ws, size_t ws_size, hipStream_t stream) {
    static int grid = 0;
    if (grid == 0) {
        if (n_in != 23 || in_sizes[0] != M * D || out_size != M * D || ws_size < WS_END) { fprintf(stderr, "kernel_launch: unexpected shapes: n_in %d in0 %d out %d ws %zu; nothing launched\n", n_in, n_in > 0 ? in_sizes[0] : -1, out_size, ws_size); grid = -1; return; }
        int dev = 0, cus = 0, per_cu = 0;
        if (hipGetDevice(&dev) != hipSuccess || hipDeviceGetAttribute(&cus, hipDeviceAttributeMultiprocessorCount, dev) != hipSuccess) { grid = -1; return; }
        if (set_attr_all( hipFuncAttributeMaxDynamicSharedMemorySize, LDS_BYTES) != hipSuccess) { fprintf(stderr, "kernel_launch: hipFuncSetAttribute failed\n"); grid = -1; return; }
        if (hipOccupancyMaxActiveBlocksPerMultiprocessor(&per_cu, (const void*)OCC_KERNEL, NWAVES * 64, LDS_BYTES) != hipSuccess || per_cu < 1) { fprintf(stderr, "kernel_launch: occupancy query reports %d\n", per_cu); per_cu = 1; }
        (void)hipGetLastError();
        grid = cus;
    }
    if (grid < 0) return;
    if (hipMemsetAsync((char*)d_ws + WS_CTL, 0, CTL_ZERO_BYTES, stream) != hipSuccess) { fprintf(stderr, "kernel_launch: memset failed\n"); return; }
    Args a{};
    for (int i = 0; i < 23; ++i) a.in[i] = (const float*)d_in[i];
    a.out = (float*)d_out; a.ws = (unsigned char*)d_ws;
    if (N_LAUNCHES == 1) {
        a.ph_lo = 0; a.ph_hi = NPHASES; a.li = 0;
#if MK_N_LAUNCHES == 1
        hipLaunchKernelGGL((hymba_fwd<0, NPHASES>), dim3(grid), dim3(NWAVES * 64), LDS_BYTES, stream, a);
#endif
    } else {
        launch_phases<0>(grid, stream, a);
    }
    const hipError_t le = hipPeekAtLastError();
    if (le != hipSuccess) fprintf(stderr, "kernel_launch: launch failed: %s\n", hipGetErrorName(le));
}
```
